# Optimizing an MI355X kernel written in HIP

```python
import jax
import jax.numpy as jnp
from jax import lax
import numpy as np

D_MODEL = 2048
BATCH = 2
SEQ = 4096
DEPTH = 2

GRID_W = 64
CTX_LEN = 256

ATT_HEADS = 8
ATT_KV_HEADS = 4
HEAD_DIM = 128
ATT_GROUP = ATT_HEADS // ATT_KV_HEADS
WINDOW = 128
ATT_BLOCK = 128
ROPE_BASE = 10000.0

HG_HEADS = 8
HG_KEY = 128
HG_VAL = (D_MODEL // 2) // HG_HEADS
HG_CHUNK = 64
NORM_EPS = 1e-6

ATT_Q_W = ATT_HEADS * HEAD_DIM
ATT_KV_W = ATT_KV_HEADS * HEAD_DIM
HG_K_W = HG_HEADS * HG_KEY
HG_V_W = HG_HEADS * HG_VAL
MIX_COLS = ('att_q', 'att_k', 'att_v', 'hg_q', 'hg_f_fwd', 'hg_f_bwd', 'hg_i', 'hg_g')
MIX_WIDTHS = (ATT_Q_W, ATT_KV_W, ATT_KV_W, HG_K_W, HG_K_W, HG_K_W, HG_V_W, HG_V_W)
CTX_SIDE_COLS = ('att_k', 'att_v', 'hg_f_fwd', 'hg_f_bwd', 'hg_i')
MIX_IN_W = ATT_Q_W + 2 * ATT_KV_W + 3 * HG_K_W + 2 * HG_V_W
MIX_OUT_IN = ATT_Q_W + HG_V_W

POOL_WINDOWS = (2, 4, 8, 16)
POOL_GROUPS = 4
POOL_CH = D_MODEL // POOL_GROUPS

MOE_GROUPS = 4
MOE_EXPERTS_PER_GROUP = 8
N_EXPERTS = MOE_GROUPS * MOE_EXPERTS_PER_GROUP
MOE_TOP_K = 2
EXPERT_FF = D_MODEL // 4
MOE_BLOCK = 128

LN_EPS = 1e-5
DEEPNORM_ALPHA = (2 * DEPTH) ** 0.25
DEEPNORM_BETA = (8 * DEPTH) ** -0.25

kernel_name = 'hybrid_swa_hgrn2_pool_hmoe_dit'


def _layer_norm(x, g, b):
    xf = x.astype(jnp.float32)
    mu = jnp.mean(xf, axis=-1, keepdims=True)
    var = jnp.mean(jnp.square(xf - mu), axis=-1, keepdims=True)
    y = (xf - mu) * lax.rsqrt(var + LN_EPS) * g.astype(jnp.float32) + b.astype(jnp.float32)
    return y.astype(x.dtype)


def _split_heads(t, n_heads):
    return t.reshape(t.shape[0], t.shape[1], n_heads, -1)


def _project(h, w_in, names):
    starts = dict(zip(MIX_COLS, np.cumsum((0,) + MIX_WIDTHS[:-1]).tolist()))
    widths = dict(zip(MIX_COLS, MIX_WIDTHS))
    if tuple(names) == MIX_COLS:
        w = w_in
    else:
        w = jnp.concatenate([w_in[:, starts[n]:starts[n] + widths[n]] for n in names], axis=1)
    p = h @ w
    cuts = np.cumsum([widths[n] for n in names])[:-1].tolist()
    return dict(zip(names, jnp.split(p, cuts, axis=-1)))


def _axial_rope(t, rows):
    n = t.shape[1]
    half = HEAD_DIM // 2
    n_freq = half // 2
    row = jnp.repeat(jnp.arange(rows), GRID_W).astype(jnp.float32)
    col = (jnp.arange(n) % GRID_W).astype(jnp.float32)
    inv_freq = ROPE_BASE ** (-jnp.arange(n_freq, dtype=jnp.float32) / n_freq)

    def rotate(seg, pos):
        ang = pos[:, None] * inv_freq[None, :]
        cos = jnp.cos(ang)[None, :, None, :]
        sin = jnp.sin(ang)[None, :, None, :]
        a, b = seg[..., :n_freq], seg[..., n_freq:]
        return jnp.concatenate([a * cos - b * sin, b * cos + a * sin], axis=-1)

    tf = t.astype(jnp.float32)
    out = jnp.concatenate([rotate(tf[..., :half], row), rotate(tf[..., half:], col)], axis=-1)
    return out.astype(t.dtype)


def _window_attention(q, k, v, k_ctx, v_ctx, sink):
    b, n = q.shape[0], q.shape[1]
    nb = n // ATT_BLOCK
    n_ctx = k_ctx.shape[1]
    scale = HEAD_DIM ** -0.5
    qb = q.reshape(b, nb, ATT_BLOCK, ATT_KV_HEADS, ATT_GROUP, HEAD_DIM)

    def band(t):
        tp = jnp.pad(t, ((0, 0), (ATT_BLOCK, ATT_BLOCK), (0, 0), (0, 0)))
        tp = tp.reshape(b, nb + 2, ATT_BLOCK, ATT_KV_HEADS, HEAD_DIM)
        return jnp.concatenate([tp[:, :-2], tp[:, 1:-1], tp[:, 2:]], axis=2)

    kb, vb = band(k), band(v)
    q_pos = jnp.arange(n).reshape(nb, ATT_BLOCK)
    k_pos = (jnp.arange(nb) * ATT_BLOCK - ATT_BLOCK)[:, None] + jnp.arange(3 * ATT_BLOCK)[None, :]
    valid = ((jnp.abs(q_pos[:, :, None] - k_pos[:, None, :]) <= WINDOW)
             & (k_pos >= 0)[:, None, :] & (k_pos < n)[:, None, :])
    s_loc = jnp.einsum('bnqhgd,bnkhd->bnhgqk', qb, kb).astype(jnp.float32) * scale
    s_loc = jnp.where(valid[None, :, None, None], s_loc, -jnp.inf)
    s_ctx = jnp.einsum('bnqhgd,bmhd->bnhgqm', qb, k_ctx).astype(jnp.float32) * scale
    s_sink = jnp.broadcast_to(sink.astype(jnp.float32).reshape(1, 1, ATT_KV_HEADS, ATT_GROUP, 1, 1),
                              s_loc.shape[:-1] + (1,))
    p = jax.nn.softmax(jnp.concatenate([s_loc, s_ctx, s_sink], axis=-1), axis=-1).astype(v.dtype)
    nk = 3 * ATT_BLOCK
    o = (jnp.einsum('bnhgqk,bnkhd->bnqhgd', p[..., :nk], vb)
         + jnp.einsum('bnhgqm,bmhd->bnqhgd', p[..., nk:nk + n_ctx], v_ctx))
    return o.reshape(b, n, ATT_HEADS * HEAD_DIM)


def _context_attention(q, k, v, sink):
    b, n_ctx = q.shape[0], q.shape[1]
    qg = q.reshape(b, n_ctx, ATT_KV_HEADS, ATT_GROUP, HEAD_DIM)
    s = jnp.einsum('blhgd,bmhd->bhglm', qg, k).astype(jnp.float32) * HEAD_DIM ** -0.5
    s_sink = jnp.broadcast_to(sink.astype(jnp.float32).reshape(1, ATT_KV_HEADS, ATT_GROUP, 1, 1),
                              s.shape[:-1] + (1,))
    p = jax.nn.softmax(jnp.concatenate([s, s_sink], axis=-1), axis=-1)[..., :n_ctx].astype(v.dtype)
    o = jnp.einsum('bhglm,bmhd->blhgd', p, v)
    return o.reshape(b, n_ctx, ATT_HEADS * HEAD_DIM)


def _hgrn2_gates(f_logit, lb):
    lbh = lb.reshape(HG_HEADS, HG_KEY)
    f = lbh + (1.0 - lbh) * jax.nn.sigmoid(_split_heads(f_logit, HG_HEADS).astype(jnp.float32))
    return 1.0 - f, jnp.log(f)


def _gla_chunked(q, k, v, log_f, s0):
    b, n, h, _ = q.shape
    n_val = v.shape[-1]
    nc = n // HG_CHUNK

    def chunks(t):
        return t.astype(jnp.float32).reshape(b, nc, HG_CHUNK, h, t.shape[-1]).transpose(1, 0, 3, 2, 4)

    incl = jnp.tril(jnp.ones((HG_CHUNK, HG_CHUNK), dtype=bool))[:, :, None]

    def step(state, inp):
        qi, ki, vi, gi = inp
        cum = jnp.cumsum(gi, axis=2)
        cum_end = cum[:, :, -1]
        o_inter = jnp.einsum('bhtk,bhkv->bhtv', qi * jnp.exp(cum), state)
        rel = jnp.exp(jnp.where(incl, cum[:, :, :, None, :] - cum[:, :, None, :, :], -jnp.inf))
        scores = jnp.einsum('bhtk,bhsk,bhtsk->bhts', qi, ki, rel)
        o = o_inter + jnp.einsum('bhts,bhsv->bhtv', scores, vi)
        new_state = (jnp.exp(cum_end)[..., None] * state
                     + jnp.einsum('bhsk,bhsv->bhkv', ki * jnp.exp(cum_end[:, :, None] - cum), vi))
        return new_state, o

    s_fin, o = lax.scan(step, s0.astype(jnp.float32), (chunks(q), chunks(k), chunks(v), chunks(log_f)))
    return o.transpose(1, 0, 3, 2, 4).reshape(b, n, h, n_val), s_fin


def _gla_final_state(k, v, log_f):
    g = log_f.astype(jnp.float32)
    to_end = jnp.flip(jnp.cumsum(jnp.flip(g, axis=1), axis=1), axis=1) - g
    return jnp.einsum('bnhk,bnhv->bhkv', k.astype(jnp.float32) * jnp.exp(to_end), v.astype(jnp.float32))


def _hgrn2_bidir(px, pc, lb_fwd, lb_bwd, ctx_out):
    b = px['hg_i'].shape[0]
    q_x = jax.nn.silu(_split_heads(px['hg_q'], HG_HEADS).astype(jnp.float32))
    v_x = _split_heads(px['hg_i'], HG_HEADS)
    v_c = _split_heads(pc['hg_i'], HG_HEADS)
    q_c = jax.nn.silu(_split_heads(pc['hg_q'], HG_HEADS).astype(jnp.float32)) if ctx_out else None
    o_x, o_c = 0.0, 0.0
    for f_name, lb, reverse in (('hg_f_fwd', lb_fwd, False), ('hg_f_bwd', lb_bwd, True)):
        seq = (lambda t: jnp.flip(t, axis=1)) if reverse else (lambda t: t)
        k_x, g_x = _hgrn2_gates(px[f_name], lb)
        k_c, g_c = _hgrn2_gates(pc[f_name], lb)
        if ctx_out:
            s0 = jnp.zeros((b, HG_HEADS, HG_KEY, HG_VAL), jnp.float32)
            oc, s_ctx = _gla_chunked(seq(q_c), seq(k_c), seq(v_c), seq(g_c), s0)
            o_c = o_c + seq(oc)
        else:
            s_ctx = _gla_final_state(seq(k_c), seq(v_c), seq(g_c))
        ox, _ = _gla_chunked(seq(q_x), seq(k_x), seq(v_x), seq(g_x), s_ctx)
        o_x = o_x + seq(ox)
    return o_x, (o_c if ctx_out else None)


def _gated_rmsnorm(o, gate, gain):
    o = o * lax.rsqrt(jnp.mean(jnp.square(o), axis=-1, keepdims=True) + NORM_EPS)
    o = o.reshape(o.shape[0], o.shape[1], HG_V_W) * gain.astype(jnp.float32)
    return (o * jax.nn.silu(gate.astype(jnp.float32))).astype(gate.dtype)


def _even_mixer(hx, hc, rows, w_in, sink, lb_fwd, lb_bwd, norm_g, w_out, ctx_out):
    px = _project(hx, w_in, MIX_COLS)
    pc = _project(hc, w_in, MIX_COLS if ctx_out else CTX_SIDE_COLS)
    q_x = _axial_rope(_split_heads(px['att_q'], ATT_HEADS), rows)
    k_x = _axial_rope(_split_heads(px['att_k'], ATT_KV_HEADS), rows)
    v_x = _split_heads(px['att_v'], ATT_KV_HEADS)
    k_c = _split_heads(pc['att_k'], ATT_KV_HEADS)
    v_c = _split_heads(pc['att_v'], ATT_KV_HEADS)
    att_x = _window_attention(q_x, k_x, v_x, k_c, v_c, sink)
    o_x, o_c = _hgrn2_bidir(px, pc, lb_fwd, lb_bwd, ctx_out)
    hg_x = _gated_rmsnorm(o_x, px['hg_g'], norm_g)
    y_x = jnp.concatenate([att_x, hg_x.astype(att_x.dtype)], axis=-1) @ w_out
    y_c = None
    if ctx_out:
        att_c = _context_attention(_split_heads(pc['att_q'], ATT_HEADS), k_c, v_c, sink)
        hg_c = _gated_rmsnorm(o_c, pc['hg_g'], norm_g)
        y_c = jnp.concatenate([att_c, hg_c.astype(att_c.dtype)], axis=-1) @ w_out
    return y_x, y_c


def _pool_mixer(h, w_in, w_grp, scale, w_out):
    b, n, _ = h.shape
    u = (h @ w_in).reshape(b, n, POOL_GROUPS, POOL_CH)
    uf = u.astype(jnp.float32)
    pref = jnp.concatenate([jnp.zeros((b, 1, POOL_GROUPS, POOL_CH), jnp.float32),
                            jnp.cumsum(uf, axis=1)], axis=1)
    t = jnp.arange(n)
    means = []
    for gi, w in enumerate(POOL_WINDOWS):
        lo = jnp.clip(t - w // 2, 0, n)
        hi = jnp.clip(t + w - w // 2, 0, n)
        pg = pref[:, :, gi]
        means.append((pg[:, hi] - pg[:, lo]) / (hi - lo).astype(jnp.float32)[None, :, None])
    mixed = (jnp.stack(means, axis=2) - uf).astype(h.dtype)
    y = jnp.einsum('bngc,gcd->bngd', mixed, w_grp).reshape(b, n, D_MODEL) * scale
    return y @ w_out


def _hier_moe(h, w_rg, b_rg, w_re, b_re, w1, w3, w2):
    n_tok, d = h.shape
    g_prob = jax.nn.softmax((h @ w_rg + b_rg).astype(jnp.float32), axis=-1)
    g_val, g_idx = lax.top_k(g_prob, 1)
    e_logits = (h @ w_re + b_re).astype(jnp.float32).reshape(n_tok, MOE_GROUPS, MOE_EXPERTS_PER_GROUP)
    e_logits = jnp.take_along_axis(e_logits, g_idx[:, :, None], axis=1)[:, 0]
    e_val, e_idx = lax.top_k(jax.nn.softmax(e_logits, axis=-1), MOE_TOP_K)
    gate = g_val * e_val / jnp.sum(e_val, axis=-1, keepdims=True)
    expert = g_idx * MOE_EXPERTS_PER_GROUP + e_idx

    n_assign = n_tok * MOE_TOP_K
    flat_e = expert.reshape(n_assign)
    order = jnp.argsort(flat_e)
    e_sorted = flat_e[order]
    counts = jnp.bincount(flat_e, length=N_EXPERTS)
    padded = (counts + MOE_BLOCK - 1) // MOE_BLOCK * MOE_BLOCK
    start = jnp.cumsum(counts) - counts
    pad_end = jnp.cumsum(padded)
    pad_start = pad_end - padded
    dest = pad_start[e_sorted] + jnp.arange(n_assign) - start[e_sorted]
    n_blocks = -(-(n_assign + N_EXPERTS * (MOE_BLOCK - 1)) // MOE_BLOCK)
    n_slots = n_blocks * MOE_BLOCK
    slot_tok = jnp.full((n_slots,), n_tok, jnp.int32).at[dest].set((order // MOE_TOP_K).astype(jnp.int32))
    slot_gate = jnp.zeros((n_slots,), h.dtype).at[dest].set(gate.reshape(n_assign)[order].astype(h.dtype))
    block_expert = jnp.minimum(jnp.searchsorted(pad_end, jnp.arange(n_blocks) * MOE_BLOCK, side='right'),
                               N_EXPERTS - 1)
    h_pad = jnp.concatenate([h, jnp.zeros((1, d), h.dtype)], axis=0)
    xb = h_pad[slot_tok].reshape(n_blocks, MOE_BLOCK, d)

    def expert_block(args):
        xe, e = args
        return (jax.nn.silu(xe @ w1[e]) * (xe @ w3[e])) @ w2[e]

    yb = lax.map(expert_block, (xb, block_expert)).reshape(n_slots, d)
    y = jnp.zeros((n_tok + 1, d), h.dtype).at[slot_tok].add(yb * slot_gate[:, None])
    return y[:n_tok]


def setup_inputs(seed: int = 0) -> dict:
    key = jax.random.key(seed)
    ks = jax.random.split(key, 24)
    d = D_MODEL
    n_even = (DEPTH + 1) // 2
    n_odd = DEPTH // 2

    def nrm(k, shape, s):
        return jax.random.normal(k, shape, jnp.float32) * s

    return {
        'x': nrm(ks[0], (BATCH, SEQ, d), 1.0),
        'c': nrm(ks[1], (BATCH, d), 1.0),
        'ctx': nrm(ks[2], (BATCH, CTX_LEN, d), 1.0),
        'c_ctx': nrm(ks[3], (d,), 1.0),
        'ada_w': nrm(ks[4], (DEPTH, d, 6 * d), 0.5 * d ** -0.5),
        'ada_b': nrm(ks[5], (DEPTH, 6 * d), 0.02),
        'ln_g': 1.0 + nrm(ks[6], (DEPTH, 2, d), 0.02),
        'ln_b': nrm(ks[7], (DEPTH, 2, d), 0.02),
        'mix_w_in': nrm(ks[8], (n_even, d, MIX_IN_W), d ** -0.5),
        'att_sink': nrm(ks[9], (n_even, ATT_HEADS), 0.5),
        'hg_lb': nrm(ks[10], (2, DEPTH + 1, HG_K_W), 0.1),
        'hg_norm_g': 1.0 + nrm(ks[11], (n_even, HG_V_W), 0.02),
        'mix_w_out': nrm(ks[12], (n_even, MIX_OUT_IN, d), MIX_OUT_IN ** -0.5 * DEEPNORM_BETA),
        'pool_w_in': nrm(ks[13], (n_odd, d, d), d ** -0.5),
        'pool_w_grp': nrm(ks[14], (n_odd, POOL_GROUPS, POOL_CH, POOL_CH), POOL_CH ** -0.5),
        'pool_scale': 1.0 + nrm(ks[15], (n_odd, d), 0.1),
        'pool_w_out': nrm(ks[16], (n_odd, d, d), d ** -0.5 * DEEPNORM_BETA),
        'rt_group_w': nrm(ks[17], (DEPTH, d, MOE_GROUPS), d ** -0.5),
        'rt_group_b': nrm(ks[18], (DEPTH, MOE_GROUPS), 0.01),
        'rt_expert_w': nrm(ks[19], (DEPTH, d, N_EXPERTS), d ** -0.5),
        'rt_expert_b': nrm(ks[20], (DEPTH, N_EXPERTS), 0.01),
        'moe_w1': nrm(ks[21], (DEPTH, N_EXPERTS, d, EXPERT_FF), d ** -0.5),
        'moe_w3': nrm(ks[22], (DEPTH, N_EXPERTS, d, EXPERT_FF), d ** -0.5),
        'moe_w2': nrm(ks[23], (DEPTH, N_EXPERTS, EXPERT_FF, d), EXPERT_FF ** -0.5 * DEEPNORM_BETA),
    }


def reference(x, c, ctx, c_ctx, ada_w, ada_b, ln_g, ln_b, mix_w_in, att_sink, hg_lb, hg_norm_g,
              mix_w_out, pool_w_in, pool_w_grp, pool_scale, pool_w_out, rt_group_w, rt_group_b,
              rt_expert_w, rt_expert_b, moe_w1, moe_w3, moe_w2):
    b, n, d = x.shape
    n_ctx = ctx.shape[1]
    rows = n // GRID_W
    lower_bounds = jnp.cumsum(jax.nn.softmax(hg_lb.astype(jnp.float32), axis=1), axis=1)
    silu_c = jax.nn.silu(c)
    silu_cc = jax.nn.silu(c_ctx)
    for l in range(DEPTH):
        even = l % 2 == 0
        ctx_next = any(j % 2 == 0 for j in range(l + 1, DEPTH))
        mod = (silu_c @ ada_w[l] + ada_b[l])[:, None, :]
        sh1, sc1, g1, sh2, sc2, g2 = jnp.split(mod, 6, axis=-1)
        hx = x * (1 + sc1) + sh1
        if even or ctx_next:
            n_cols = 6 * d if ctx_next else 2 * d
            mc = jnp.split(silu_cc @ ada_w[l][:, :n_cols] + ada_b[l][:n_cols], n_cols // d)
            hc = ctx * (1 + mc[1]) + mc[0]
        if even:
            e = l // 2
            y_x, y_c = _even_mixer(hx, hc, rows, mix_w_in[e], att_sink[e], lower_bounds[0, l],
                                   lower_bounds[1, l], hg_norm_g[e], mix_w_out[e], ctx_next)
        else:
            o = l // 2
            y_x = _pool_mixer(hx, pool_w_in[o], pool_w_grp[o], pool_scale[o], pool_w_out[o])
            y_c = _pool_mixer(hc, pool_w_in[o], pool_w_grp[o], pool_scale[o], pool_w_out[o]) if ctx_next else None
        x = _layer_norm(DEEPNORM_ALPHA * x + g1 * y_x, ln_g[l, 0], ln_b[l, 0])
        tokens = (x * (1 + sc2) + sh2).reshape(b * n, d)
        if ctx_next:
            ctx = _layer_norm(DEEPNORM_ALPHA * ctx + mc[2] * y_c, ln_g[l, 0], ln_b[l, 0])
            tokens = jnp.concatenate([tokens, (ctx * (1 + mc[4]) + mc[3]).reshape(b * n_ctx, d)], axis=0)
        y = _hier_moe(tokens, rt_group_w[l], rt_group_b[l], rt_expert_w[l], rt_expert_b[l],
                      moe_w1[l], moe_w3[l], moe_w2[l])
        x = _layer_norm(DEEPNORM_ALPHA * x + g2 * y[:b * n].reshape(b, n, d), ln_g[l, 1], ln_b[l, 1])
        if ctx_next:
            ctx = _layer_norm(DEEPNORM_ALPHA * ctx + mc[5] * y[b * n:].reshape(b, n_ctx, d),
                              ln_g[l, 1], ln_b[l, 1])
    return x
```

```cpp
#include <hip/hip_runtime.h>
#include <cstdio>
#include <cstdint>

namespace pg8 {
#define PG8_LAS __attribute__((address_space(3)))
typedef unsigned short bf16_t;
typedef short bf16x8 __attribute__((ext_vector_type(8)));
typedef float f32x4 __attribute__((ext_vector_type(4)));
typedef unsigned u32x4 __attribute__((ext_vector_type(4)));
constexpr int BM = 256, BK = 64, HALF = 128, HTB = HALF * BK * 2  , STAGE_BYTES = 8 * HTB, NXCD = 8, WGM = 8;

__host__ __device__ __forceinline__ int lds_byte(int r, int c) { const int st = (r >> 4) * 2 + (c >> 5), rr = r & 15, cc = c & 31, ob = rr * 64 + cc * 2; return st * 1024 + (ob ^ (((ob >> 9) & 1) << 5)); }
__host__ __device__ __forceinline__ void stage_rc(int b, int& R, int& C) { const int st = b / 1024, sb = b % 1024, swz = sb ^ (((sb >> 9) & 1) << 5); R = (st >> 1) * 16 + swz / 64; C = (st & 1) * 32 + (swz % 64) / 2; }
__host__ __device__ __forceinline__ int perm32(int rho) { const int n = rho >> 4, i = rho & 15; return 8 * (i >> 2) + 4 * n + (i & 3); }

struct Unit { int pm, pn; };
struct Gemm { const bf16_t* A; const bf16_t* Bt; int K, lda, ldb; };
__device__ __forceinline__ unsigned cvt_pk_bf16(float lo, float hi) { unsigned r; asm volatile("v_cvt_pk_bf16_f32 %0, %1, %2" : "=v"(r) : "v"(lo), "v"(hi)); return r; }
template <class Epi, class Sched, bool ALIGN_EPI = false, bool SP2 = false>
__device__ __forceinline__ void gemm_phase(PG8_LAS unsigned char* lds, const Gemm g, const Sched& S, const Epi& E) {
    const int tid = threadIdx.x, wid = __builtin_amdgcn_readfirstlane(tid >> 6), lane = tid & 63, wr = wid >> 2, wc = wid & 3, fr = lane & 15, fq = lane >> 4;
    const int K = g.K, nt = K / BK;
    unsigned voffA[2], voffB[2];
#pragma unroll
    for (int i = 0; i < 2; ++i) { int R, C; stage_rc(tid * 16 + i * 8192, R, C); const int Rb = Epi::PERM ? ((R & ~31) + perm32(R & 31)) : R;
        voffA[i] = (unsigned)(R * g.lda + C) * 2u; voffB[i] = (unsigned)(Rb * g.ldb + C) * 2u; }
    const size_t kstep = (size_t)(BK * 2);
    const size_t hsA = (size_t)HALF * g.lda * 2, hsB = (size_t)HALF * g.ldb * 2;
    const unsigned ldsw = (unsigned)wid * 1024u;
    const int aoff = lds_byte(wr * 64 + fr, fq * 8), boff = lds_byte(wc * 32 + fr, fq * 8);
#define PG8_SA(b, h) (((b) * 2 + (h)) * HTB)
#define PG8_SB(b, h) ((4 + (b) * 2 + (h)) * HTB)
#define PG8_STAGE(bufoff, gbase, voff) do { _Pragma("unroll") for (int _i = 0; _i < 2; ++_i) \
        __builtin_amdgcn_global_load_lds((const unsigned*)((const char*)(gbase) + (voff)[_i]), (PG8_LAS unsigned*)(lds + (bufoff) + ldsw + _i * 8192), 16, 0, 0); } while (0)
#define PG8_LDA(dst, b, h) do { _Pragma("unroll") for (int m = 0; m < 4; ++m) _Pragma("unroll") for (int k = 0; k < 2; ++k) dst[m][k] = *(const PG8_LAS bf16x8*)(lds + PG8_SA(b, h) + aoff + m * 2048 + k * 1024); } while (0)
#define PG8_LDB(dst, b, h) do { _Pragma("unroll") for (int n = 0; n < 2; ++n) _Pragma("unroll") for (int k = 0; k < 2; ++k) dst[n][k] = *(const PG8_LAS bf16x8*)(lds + PG8_SB(b, h) + boff + n * 2048 + k * 1024); } while (0)
#define PG8_MMA(ai, bj, At, Bt) do { __builtin_amdgcn_s_setprio(1); _Pragma("unroll") for (int m = 0; m < 4; ++m) _Pragma("unroll") for (int n = 0; n < 2; ++n) _Pragma("unroll") for (int k = 0; k < 2; ++k) \
        acc[ai][bj][m][n] = __builtin_amdgcn_mfma_f32_16x16x32_bf16(Bt[n][k], At[m][k], acc[ai][bj][m][n], 0, 0, 0); __builtin_amdgcn_s_setprio(0); } while (0)
#define PG8_WAIT_V(n) asm volatile("s_waitcnt vmcnt(" #n ")" ::: "memory")
#define PG8_WAIT_L(n) asm volatile("s_waitcnt lgkmcnt(" #n ")" ::: "memory")
#define PG8_BAR __builtin_amdgcn_s_barrier()
#define PG8_SCHED __builtin_amdgcn_sched_barrier(0)
    Unit cur, nxt; int ui = 0;
    if (!S.next(0, cur)) return;
    f32x4 acc[2][2][4][2];
#pragma unroll
    for (int a = 0; a < 2; ++a)
#pragma unroll
        for (int b = 0; b < 2; ++b)
#pragma unroll
            for (int m = 0; m < 4; ++m)
#pragma unroll
                for (int n = 0; n < 2; ++n) acc[a][b][m][n] = (f32x4){0.f, 0.f, 0.f, 0.f};
    bf16x8 At[4][2], B0[2][2], B1[2][2];
    const char* cA = (const char*)g.A + S.aoff(cur); const char* cB = (const char*)g.Bt + S.boff(cur);
    S.a_ready(cur);
    if constexpr (SP2) {
        PG8_STAGE(PG8_SB(0, 0), cB, voffB); PG8_STAGE(PG8_SB(0, 1), cB + hsB, voffB); PG8_STAGE(PG8_SA(0, 0), cA, voffA); PG8_STAGE(PG8_SA(0, 1), cA + hsA, voffA);
        if (wr == 1) PG8_BAR;
        PG8_WAIT_V(2); PG8_BAR;
        PG8_STAGE(PG8_SB(1, 0), cB + kstep, voffB); PG8_STAGE(PG8_SA(1, 0), cA + kstep, voffA); PG8_STAGE(PG8_SB(1, 1), cB + hsB + kstep, voffB);
        PG8_WAIT_V(6); PG8_BAR;
    } else {
        PG8_STAGE(PG8_SB(0, 0), cB, voffB); PG8_STAGE(PG8_SA(0, 0), cA, voffA); PG8_STAGE(PG8_SB(0, 1), cB + hsB, voffB); PG8_STAGE(PG8_SA(0, 1), cA + hsA, voffA);
        if (wr == 1) PG8_BAR;
        PG8_WAIT_V(4); PG8_BAR;
        PG8_STAGE(PG8_SB(1, 0), cB + kstep, voffB); PG8_STAGE(PG8_SA(1, 0), cA + kstep, voffA); PG8_STAGE(PG8_SB(1, 1), cB + hsB + kstep, voffB);
        PG8_WAIT_V(6); PG8_BAR;
    }
    for (;;) {
        const bool has_next = S.next(ui + 1, nxt);
        const char* nA = has_next ? (const char*)g.A + S.aoff(nxt) : cA; const char* nB = has_next ? (const char*)g.Bt + S.boff(nxt) : cB;
        for (int t = 0; t < nt; t += 2) {
            const bool last = (t == nt - 2);
            const char* a1 = cA + (size_t)(t + 1) * kstep;
            const char* a2 = last ? nA : cA + (size_t)(t + 2) * kstep; const char* b2 = last ? nB : cB + (size_t)(t + 2) * kstep;
            const char* a3 = a2 + kstep; const char* b3 = b2 + kstep;
            if (last && has_next) S.a_ready(nxt);
            if constexpr (SP2) {
            PG8_LDB(B0, 0, 0); PG8_LDB(B1, 0, 1); PG8_SCHED; PG8_LDA(At, 0, 0); PG8_STAGE(PG8_SA(1, 1), a1 + hsA, voffA);
            PG8_WAIT_V(8); PG8_WAIT_L(0); PG8_BAR; PG8_MMA(0, 0, At, B0); PG8_MMA(0, 1, At, B1); PG8_BAR; PG8_SCHED;
            PG8_LDA(At, 0, 1); PG8_STAGE(PG8_SB(0, 0), b2, voffB); PG8_STAGE(PG8_SB(0, 1), b2 + hsB, voffB); PG8_STAGE(PG8_SA(0, 0), a2, voffA);
            PG8_WAIT_V(8); PG8_WAIT_L(0); PG8_BAR; PG8_MMA(1, 0, At, B0); PG8_MMA(1, 1, At, B1); PG8_BAR; PG8_SCHED;
            PG8_LDB(B0, 1, 0); PG8_LDB(B1, 1, 1); PG8_SCHED; PG8_LDA(At, 1, 0); PG8_STAGE(PG8_SA(0, 1), a2 + hsA, voffA);
            PG8_WAIT_V(8); PG8_WAIT_L(0); PG8_BAR; PG8_MMA(0, 0, At, B0); PG8_MMA(0, 1, At, B1); PG8_BAR; PG8_SCHED;
            PG8_LDA(At, 1, 1); PG8_STAGE(PG8_SB(1, 0), b3, voffB); PG8_STAGE(PG8_SB(1, 1), b3 + hsB, voffB); PG8_STAGE(PG8_SA(1, 0), a3, voffA);
            PG8_WAIT_V(8); PG8_WAIT_L(0); PG8_BAR; PG8_MMA(1, 0, At, B0); PG8_MMA(1, 1, At, B1); PG8_BAR; PG8_SCHED;
            } else {
            PG8_LDB(B0, 0, 0); PG8_SCHED; PG8_LDA(At, 0, 0); PG8_STAGE(PG8_SA(1, 1), a1 + hsA, voffA);
            PG8_WAIT_L(8); PG8_BAR; PG8_WAIT_L(0); PG8_MMA(0, 0, At, B0); PG8_BAR; PG8_SCHED;
            PG8_LDB(B1, 0, 1); PG8_STAGE(PG8_SB(0, 0), b2, voffB);
            PG8_BAR; PG8_WAIT_L(0); PG8_MMA(0, 1, At, B1); PG8_BAR;
            PG8_LDA(At, 0, 1); PG8_STAGE(PG8_SA(0, 0), a2, voffA);
            PG8_BAR; PG8_WAIT_L(0); PG8_MMA(1, 0, At, B0); PG8_BAR; PG8_SCHED;
            PG8_STAGE(PG8_SB(0, 1), b2 + hsB, voffB);
            PG8_WAIT_V(6); PG8_BAR; PG8_MMA(1, 1, At, B1); PG8_BAR;
            PG8_LDB(B0, 1, 0); PG8_SCHED; PG8_LDA(At, 1, 0); PG8_STAGE(PG8_SA(0, 1), a2 + hsA, voffA);
            PG8_WAIT_L(8); PG8_BAR; PG8_WAIT_L(0); PG8_MMA(0, 0, At, B0); PG8_BAR; PG8_SCHED;
            PG8_LDB(B1, 1, 1); PG8_STAGE(PG8_SB(1, 0), b3, voffB);
            PG8_BAR; PG8_WAIT_L(0); PG8_MMA(0, 1, At, B1); PG8_BAR;
            PG8_LDA(At, 1, 1); PG8_STAGE(PG8_SA(1, 0), a3, voffA);
            PG8_BAR; PG8_WAIT_L(0); PG8_MMA(1, 0, At, B0); PG8_BAR; PG8_SCHED;
            PG8_STAGE(PG8_SB(1, 1), b3 + hsB, voffB);
            PG8_WAIT_V(6); PG8_BAR; PG8_MMA(1, 1, At, B1); PG8_BAR;
            }
        }
        if constexpr (ALIGN_EPI) { if (wr == 0) PG8_BAR; }
        if constexpr (!Epi::AFTER_DRAIN) { E(acc, cur, wr, wc, fr, fq); S.done(cur); }
        if (!has_next) break;
#pragma unroll
        for (int a = 0; a < 2; ++a)
#pragma unroll
            for (int b = 0; b < 2; ++b)
#pragma unroll
                for (int m = 0; m < 4; ++m)
#pragma unroll
                    for (int n = 0; n < 2; ++n) acc[a][b][m][n] = (f32x4){0.f, 0.f, 0.f, 0.f};
        cur = nxt; cA = nA; cB = nB; ++ui;
        if constexpr (ALIGN_EPI) { if (wr == 1) PG8_BAR; }
    }
    PG8_WAIT_V(0);
    if constexpr (!ALIGN_EPI) { if (wr == 0) PG8_BAR; }
    PG8_BAR;
    if constexpr (Epi::AFTER_DRAIN) { E.fused(acc, cur, wr, wc, fr, fq, lds, wid, lane); S.done(cur); }
#undef PG8_SA
#undef PG8_SB
#undef PG8_STAGE
#undef PG8_LDA
#undef PG8_LDB
#undef PG8_MMA
#undef PG8_WAIT_V
#undef PG8_WAIT_L
#undef PG8_BAR
#undef PG8_SCHED
}
}
namespace pg8 {
struct StaticOrder {
    int nM, nN, nwg, G, c, lda, ldb;
    __host__ __device__ void init(int M, int N, int G_, int c_, int lda_, int ldb_) { nM = M / BM; nN = N / BM; nwg = nM * nN; G = G_; c = c_; lda = lda_; ldb = ldb_; }
    __host__ __device__ bool next(int i, Unit& u) const {
        const long L = (long)i * G + c; if (L >= nwg) return false;
        int wgid = (int)L; { const int q = nwg / NXCD, r = nwg % NXCD, xcd = wgid % NXCD, off = wgid / NXCD; wgid = (xcd < r ? xcd * (q + 1) : r * (q + 1) + (xcd - r) * q) + off; }
        const int nig = WGM * nN, gid = wgid / nig, fm = gid * WGM, gsz = (nM - fm) < WGM ? (nM - fm) : WGM;
        u.pm = fm + ((wgid % nig) % gsz); u.pn = (wgid % nig) / gsz; return true;
    }
    __device__ __forceinline__ size_t aoff(const Unit& u) const { return (size_t)u.pm * BM * lda * 2; }
    __device__ __forceinline__ size_t boff(const Unit& u) const { return (size_t)u.pn * BM * ldb * 2; }
    __device__ __forceinline__ void a_ready(const Unit&) const {}
    __device__ __forceinline__ void done(const Unit&) const {}
};
struct InprojOrder {
    static constexpr int NCTXU = 32, NLAT = 32 * 28, NWG = NCTXU + NLAT;
    int G, c, lda, ldb; unsigned* cnt;
    __device__ __forceinline__ void init(int G_, int c_, int lda_, int ldb_, unsigned* cnt_) { G = G_; c = c_; lda = lda_; ldb = ldb_; cnt = cnt_; }
    __device__ __forceinline__ bool next(int i, Unit& u) const {
        const long L = (long)i * G + c; if (L >= NWG) return false;
        if (L < NCTXU) { const int t = (int)L & 15; u.pm = 32 + ((int)L >> 4); u.pn = t < 4 ? 4 + t : 8 + t; return true; }
        int wgid = (int)L - NCTXU; { const int q = NLAT / NXCD, xcd = wgid % NXCD, off = wgid / NXCD; wgid = xcd * q + off; }
        const int nig = WGM * 28, gid = wgid / nig, fm = gid * WGM;
        u.pm = fm + ((wgid % nig) % WGM); u.pn = (wgid % nig) / WGM; return true;
    }
    __device__ __forceinline__ size_t aoff(const Unit& u) const { return (size_t)u.pm * BM * lda * 2; }
    __device__ __forceinline__ size_t boff(const Unit& u) const { return (size_t)u.pn * BM * ldb * 2; }
    __device__ __forceinline__ void a_ready(const Unit&) const {}
    __device__ __forceinline__ void done(const Unit& u) const {
        if (!cnt || u.pm < 32) return;
        asm volatile("s_waitcnt vmcnt(0)" ::: "memory"); __syncthreads();
        if (threadIdx.x == 0) { __builtin_amdgcn_fence(__ATOMIC_RELEASE, "agent"); asm volatile("s_waitcnt vmcnt(0)" ::: "memory");
            (void)__hip_atomic_fetch_add(cnt, 1u, __ATOMIC_RELAXED, __HIP_MEMORY_SCOPE_AGENT); }
    }
};
struct FoldOrder {
    int idx, stride, lda, ldb;
    __device__ __forceinline__ bool next(int i, Unit& u) const { const int L = idx + i * stride; if (idx < 0 || L >= 64) return false; u.pm = L >> 3; u.pn = L & 7; return true; }
    __device__ __forceinline__ size_t aoff(const Unit& u) const { return (size_t)u.pm * BM * lda * 2 + (size_t)(u.pn >> 1) * 512 * 2; }
    __device__ __forceinline__ size_t boff(const Unit& u) const { return (size_t)u.pn * BM * ldb * 2; }
    __device__ __forceinline__ void a_ready(const Unit&) const {}
    __device__ __forceinline__ void done(const Unit&) const {}
};
struct EpiF32 {
    static constexpr bool PERM = false, AFTER_DRAIN = false;
    float* C; int ldc;
    __device__ __forceinline__ void operator()(const f32x4 (&acc)[2][2][4][2], const Unit& u, int wr, int wc, int fr, int fq) const {
        const int row0 = u.pm * BM + wr * 64 + fr, col0 = u.pn * BM + wc * 32 + 4 * fq;
#pragma unroll
        for (int ai = 0; ai < 2; ++ai)
#pragma unroll
            for (int m = 0; m < 4; ++m) { float* rowp = C + (size_t)(row0 + ai * HALF + m * 16) * ldc + col0;
#pragma unroll
                for (int bj = 0; bj < 2; ++bj)
#pragma unroll
                    for (int n = 0; n < 2; ++n) *(f32x4*)(rowp + bj * HALF + n * 16) = acc[ai][bj][m][n]; }
    }
};
struct EpiBf16 {
    static constexpr bool PERM = true, AFTER_DRAIN = false;
    bf16_t* O; int ldc; const float* scale; int ncolt; int silu_lo = 0, silu_hi = 0, silu_lo2 = 0, silu_hi2 = 0;
    int rope_tiles = 0, rope_rows = 0;
    __device__ __forceinline__ void operator()(const f32x4 (&acc)[2][2][4][2], const Unit& u, int wr, int wc, int fr, int fq) const {
        const int row0 = u.pm * BM + wr * 64 + fr, col0 = (u.pn % ncolt) * BM + wc * 32 + 8 * fq;
        const int ct = u.pn % ncolt; const bool act = (ct >= silu_lo && ct < silu_hi) || (ct >= silu_lo2 && ct < silu_hi2);
        const bool rp = ct < rope_tiles && u.pm * BM < rope_rows;
        float invf[4] = {0.f, 0.f, 0.f, 0.f};
        if (rp) {
#pragma unroll
            for (int j = 0; j < 4; ++j) invf[j] = __builtin_amdgcn_exp2f(-(float)(16 * (wc & 1) + 4 * fq + j) * (13.287712379549449f / 32.0f)) * 0.15915494309189535f; }
        f32x4 sv[2][2];
#pragma unroll
        for (int bj = 0; bj < 2; ++bj)
#pragma unroll
            for (int n = 0; n < 2; ++n) sv[bj][n] = scale ? *(const f32x4*)(scale + col0 + bj * HALF + 4 * n) : (f32x4){1.f, 1.f, 1.f, 1.f};
#pragma unroll
        for (int ai = 0; ai < 2; ++ai)
#pragma unroll
            for (int m = 0; m < 4; ++m) { bf16_t* rowp = O + (size_t)(row0 + ai * HALF + m * 16) * ldc + col0;
                float pos = 0.f;
                if (rp) { const int nseq = (row0 + ai * HALF + m * 16) & 4095; pos = (wc >> 1) ? (float)(nseq & 63) : (float)(nseq >> 6); }
#pragma unroll
                for (int bj = 0; bj < 2; ++bj) { f32x4 v0 = acc[ai][bj][m][0] * sv[bj][0], v1 = acc[ai][bj][m][1] * sv[bj][1];
                    if (rp) {
#pragma unroll
                        for (int j = 0; j < 4; ++j) { const float rev = pos * invf[j], rc = __builtin_amdgcn_cosf(rev), rs = __builtin_amdgcn_sinf(rev), xa = v0[j], xb = v1[j]; v0[j] = xa * rc - xb * rs; v1[j] = xb * rc + xa * rs; } }
                    if (act) {
#pragma unroll
                        for (int i = 0; i < 4; ++i) { v0[i] = v0[i] * __builtin_amdgcn_rcpf(1.f + __builtin_amdgcn_exp2f(-1.4426950408889634f * v0[i])); v1[i] = v1[i] * __builtin_amdgcn_rcpf(1.f + __builtin_amdgcn_exp2f(-1.4426950408889634f * v1[i])); } }
                    u32x4 w; w.x = cvt_pk_bf16(v0[0], v0[1]); w.y = cvt_pk_bf16(v0[2], v0[3]); w.z = cvt_pk_bf16(v1[0], v1[1]); w.w = cvt_pk_bf16(v1[2], v1[3]);
                    *(u32x4*)(rowp + bj * HALF) = w; } }
    }
};
template <unsigned N> struct PoolC { static constexpr unsigned value = N; };
struct EpiPool {
    static constexpr bool PERM = true, AFTER_DRAIN = true;
    bf16_t* MX; unsigned char* halo; unsigned* hcnt; int ldc; int tiles_per_seq;
    __device__ __forceinline__ void fused(f32x4 (&acc)[2][2][4][2], const Unit& u, int wr, int wc, int fr, int fq, PG8_LAS unsigned char* lds, int wid, int lane) const {
        const int tid = wid * 64 + lane;
        PG8_LAS unsigned char* T = lds; PG8_LAS unsigned char* HL = lds + 131072;
        const __amdgpu_buffer_rsrc_t hrs = __builtin_amdgcn_make_buffer_rsrc((void*)halo, 0, 0x7fffffff, 0x00020000);
        const unsigned hme = (unsigned)(u.pm * 8 + u.pn) * 8192u;
#pragma unroll
        for (int ai = 0; ai < 2; ++ai)
#pragma unroll
            for (int m = 0; m < 4; ++m) { const int row = ai * HALF + wr * 64 + m * 16 + fr;
#pragma unroll
                for (int bj = 0; bj < 2; ++bj) { const int ch = bj * 16 + wc * 4 + fq; const f32x4 v0 = acc[ai][bj][m][0], v1 = acc[ai][bj][m][1];
                    u32x4 w; w.x = cvt_pk_bf16(v0[0], v0[1]); w.y = cvt_pk_bf16(v0[2], v0[3]); w.z = cvt_pk_bf16(v1[0], v1[1]); w.w = cvt_pk_bf16(v1[2], v1[3]);
                    *(PG8_LAS u32x4*)(T + row * 512 + 16 * (ch ^ (row & 15))) = w;
                    if (row < 8 || row >= 248) __builtin_amdgcn_raw_buffer_store_b128(w, hrs, (int)(hme + (unsigned)((row < 8 ? row : row - 240) * 512 + ch * 16)), 0, 16); } }
        asm volatile("s_waitcnt vmcnt(0)" ::: "memory"); __syncthreads();
        if (tid == 0) __hip_atomic_fetch_add(hcnt + u.pm * 8 + u.pn, 1u, __ATOMIC_RELAXED, __HIP_MEMORY_SCOPE_AGENT);
        const int nloc = u.pm % tiles_per_seq; const bool hasup = nloc != 0, hasdn = nloc != tiles_per_seq - 1;
        const int W = 2 << (u.pn >> 1), hW = W >> 1, n0 = nloc * BM, nseq = tiles_per_seq * BM;
        auto strip_pool = [&](const int strip, const int ch, auto edge) __attribute__((always_inline)) {
            constexpr bool EDGE = decltype(edge)::value != 0u;
            const int r0 = strip * 16;
            float sum[8] = {0.f, 0.f, 0.f, 0.f, 0.f, 0.f, 0.f, 0.f};
            auto rd = [&](int q) -> u32x4 { if (EDGE) { if (q < 0) return *(const PG8_LAS u32x4*)(HL + (8 + q) * 512 + ch * 16); if (q >= BM) return *(const PG8_LAS u32x4*)(HL + (8 + q - BM) * 512 + ch * 16); }
                return *(const PG8_LAS u32x4*)(T + q * 512 + 16 * (ch ^ (q & 15))); };
            auto acc8 = [&](const u32x4 w, auto neg) { constexpr bool NEG = decltype(neg)::value != 0u;
                const float f0 = __builtin_bit_cast(float, w.x << 16), f1 = __builtin_bit_cast(float, w.x & 0xffff0000u), f2 = __builtin_bit_cast(float, w.y << 16), f3 = __builtin_bit_cast(float, w.y & 0xffff0000u),
                            f4 = __builtin_bit_cast(float, w.z << 16), f5 = __builtin_bit_cast(float, w.z & 0xffff0000u), f6 = __builtin_bit_cast(float, w.w << 16), f7 = __builtin_bit_cast(float, w.w & 0xffff0000u);
                if (NEG) { sum[0] -= f0; sum[1] -= f1; sum[2] -= f2; sum[3] -= f3; sum[4] -= f4; sum[5] -= f5; sum[6] -= f6; sum[7] -= f7; } else { sum[0] += f0; sum[1] += f1; sum[2] += f2; sum[3] += f3; sum[4] += f4; sum[5] += f5; sum[6] += f6; sum[7] += f7; } };
            auto valid = [&](int q) -> bool { if (!EDGE) return true; const int p = n0 + q; return p >= 0 && p < nseq; };
            for (int q = r0 - hW; q < r0 + hW; ++q) if (valid(q)) acc8(rd(q), PoolC<0u>{});
            bf16_t* orow = MX + (size_t)(u.pm * BM + r0) * ldc + u.pn * BM + ch * 8;
#pragma unroll 4
            for (int t = r0; t < r0 + 16; ++t) {
                float inv;
                if (EDGE) { const int plo = n0 + t - hW, phi = n0 + t + hW; inv = 1.f / (float)((phi < nseq ? phi : nseq) - (plo > 0 ? plo : 0)); } else inv = 1.f / (float)W;
                const u32x4 sv = rd(t);
                u32x4 o; o.x = cvt_pk_bf16(sum[0] * inv - __builtin_bit_cast(float, sv.x << 16), sum[1] * inv - __builtin_bit_cast(float, sv.x & 0xffff0000u)); o.y = cvt_pk_bf16(sum[2] * inv - __builtin_bit_cast(float, sv.y << 16), sum[3] * inv - __builtin_bit_cast(float, sv.y & 0xffff0000u));
                o.z = cvt_pk_bf16(sum[4] * inv - __builtin_bit_cast(float, sv.z << 16), sum[5] * inv - __builtin_bit_cast(float, sv.z & 0xffff0000u)); o.w = cvt_pk_bf16(sum[6] * inv - __builtin_bit_cast(float, sv.w << 16), sum[7] * inv - __builtin_bit_cast(float, sv.w & 0xffff0000u));
                *(u32x4*)(orow + (size_t)(t - r0) * ldc) = o;
                if (valid(t - hW)) acc8(rd(t - hW), PoolC<1u>{});
                if (valid(t + hW)) acc8(rd(t + hW), PoolC<0u>{});
            }
        };
        if (tid < 448) strip_pool(1 + (tid >> 5), tid & 31, PoolC<0u>{});
        if (tid == 0) { unsigned sp = 0;
            while ((hasup && __hip_atomic_load(hcnt + (u.pm - 1) * 8 + u.pn, __ATOMIC_RELAXED, __HIP_MEMORY_SCOPE_AGENT) < 1u) || (hasdn && __hip_atomic_load(hcnt + (u.pm + 1) * 8 + u.pn, __ATOMIC_RELAXED, __HIP_MEMORY_SCOPE_AGENT) < 1u)) {
                __builtin_amdgcn_s_sleep(2); if (++sp > (1u << 22)) break; } }
        __syncthreads();
        { const int hrow = tid >> 5, ch = tid & 31; const bool up = hrow < 8;
          if (up ? hasup : hasdn) { const unsigned src = (unsigned)((up ? u.pm - 1 : u.pm + 1) * 8 + u.pn) * 8192u + (unsigned)((up ? hrow + 8 : hrow - 8) * 512 + ch * 16);
              *(PG8_LAS u32x4*)(HL + hrow * 512 + ch * 16) = __builtin_amdgcn_raw_buffer_load_b128(hrs, (int)src, 0, 16); } }
        __syncthreads();
        if (tid < 64) strip_pool((tid >> 5) ? 15 : 0, tid & 31, PoolC<1u>{});
    }
};
struct EpiSwiglu {
    static constexpr bool PERM = true, AFTER_DRAIN = false;
    bf16_t* H;
    __device__ __forceinline__ void operator()(const f32x4 (&acc)[2][2][4][2], const Unit& u, int wr, int wc, int fr, int fq) const {
        const int row0 = u.pm * BM + wr * 64 + fr, col0 = (u.pn & 3) * 128 + wc * 32 + 8 * fq;
#pragma unroll
        for (int ai = 0; ai < 2; ++ai)
#pragma unroll
            for (int m = 0; m < 4; ++m) { bf16_t* rowp = H + (size_t)(row0 + ai * HALF + m * 16) * 512 + col0;
                float h[8];
#pragma unroll
                for (int n = 0; n < 2; ++n)
#pragma unroll
                    for (int i = 0; i < 4; ++i) { const float a = acc[ai][0][m][n][i], b = acc[ai][1][m][n][i]; h[n * 4 + i] = a * __builtin_amdgcn_rcpf(1.f + __builtin_amdgcn_exp2f(-1.4426950408889634f * a)) * b; }
                u32x4 w; w.x = cvt_pk_bf16(h[0], h[1]); w.y = cvt_pk_bf16(h[2], h[3]); w.z = cvt_pk_bf16(h[4], h[5]); w.w = cvt_pk_bf16(h[6], h[7]);
                asm volatile("global_store_dwordx4 %0, %1, off sc1\n\ts_nop 1" :: "v"(rowp), "v"(w) : "memory"); }
    }
};
}
namespace pg8 {
__device__ __forceinline__ unsigned bimg(unsigned k, unsigned n) { return 512u * k + 16u * ((n >> 3) ^ (((k & 3u) << 2) | ((k >> 2) & 3u))) + 2u * (n & 7u); }
#define PG8_TR2(d0, d1, a0, a1, OFF) asm volatile("ds_read_b64_tr_b16 %0, %2 offset:" #OFF "\n\tds_read_b64_tr_b16 %1, %3 offset:" #OFF : "=&v"(d0), "=&v"(d1) : "v"(a0), "v"(a1) : "memory")
typedef unsigned short u16x4 __attribute__((ext_vector_type(4)));
__device__ __forceinline__ bf16x8 cat44(u16x4 lo, u16x4 hi) { bf16x8 r; r[0] = (short)lo[0]; r[1] = (short)lo[1]; r[2] = (short)lo[2]; r[3] = (short)lo[3]; r[4] = (short)hi[0]; r[5] = (short)hi[1]; r[6] = (short)hi[2]; r[7] = (short)hi[3]; return r; }

struct MoeCfg { const bf16_t* A; int lda; const int* arow; int K; const float* W0; const float* W1; int ldn; size_t estride; int colstep; int NT; };
struct FusedOrder {
    const PG8_LAS int* tab; int G, c, T;
    __device__ __forceinline__ void init(const PG8_LAS int* tab_, int G_, int c_) { tab = tab_; G = G_; c = c_; int t = 0; _Pragma("unroll 1") for (int e = 0; e < 32; ++e) t += tab[e]; T = t; }
    __device__ __forceinline__ bool unit(int L, int NT, Unit& u) const {
        int acc = 0, e = 0, n = 0;
#pragma unroll 1
        for (; e < 32; ++e) { n = tab[e]; if (L < NT * (acc + n)) break; acc += n; }
        if (e >= 32) return false;
        const int q = L - NT * acc, j = q / n, t = acc + (q - j * n);
        u.pm = t; u.pn = e * NT + j; return true;
    }
    __device__ __forceinline__ bool next(int i, Unit& u, int& type, int& kh, int& ub) const {
        const int nU = 4 * T, R0 = (nU + G - 1) / G; int nFull = nU;
        if (R0 > 1 && 2 * (nU - G * (R0 - 1)) <= G) nFull = G * (R0 - 1);
        const int nG1 = nFull + 2 * (nU - nFull), nG2 = 8 * T, R = (nG1 + G - 1) / G, nH = nG1 - G * (R - 1), nL = G - nH, CU = 3;
        const int n1 = (c < nG1) ? ((nG1 - 1 - c) / G + 1) : 0; const bool light = n1 < R;
        kh = -1; ub = 0;
        if (i < n1) { int L = c + G * i; type = 0;
            if (L >= nFull) { const int Lb = L - nFull; kh = Lb & 1; ub = Lb >> 1; L = nFull + ub; }
            return unit(L, 4, u); }
        const int i2 = i - n1; int u2;
        if (light && i2 < CU) u2 = i2 * nL + (c - nH); else u2 = CU * nL + c + G * (i2 - (light ? CU : 0));
        if (u2 >= nG2) return false;
        type = 1;
        return unit(u2, 8, u);
    }
};
template <int MODE, class EpiA, class EpiB>
__device__ __forceinline__ bool moe_run(PG8_LAS unsigned char* lds, const MoeCfg& c0, const MoeCfg& c1, unsigned* mcnt, unsigned char* xbuf, unsigned* xcnt, const FusedOrder& S, const EpiA& EA, const EpiB& EB,
                                        int& ui, Unit& cur, int& type, int& kh, int& ub) {
    typedef EpiA Epi;
    constexpr bool T1 = MODE == 2, SPLIT = MODE == 1;
#define F_SA(b, h) (((b) * 2 + (h)) * 8192)
#define F_SB(b) (32768 + (b) * 16384)
#define F_UNIFORM() do { cur.pm = __builtin_amdgcn_readfirstlane(cur.pm); cur.pn = __builtin_amdgcn_readfirstlane(cur.pn); type = __builtin_amdgcn_readfirstlane(type); kh = __builtin_amdgcn_readfirstlane(kh); ub = __builtin_amdgcn_readfirstlane(ub); } while (0)
    for (;;) {
        if ((type ? 2 : (kh >= 0 ? 1 : 0)) != MODE) return true;
    int tz_ = threadIdx.x; asm volatile("" : "+v"(tz_));
    const int tid = tz_, wid = __builtin_amdgcn_readfirstlane(tid >> 6), lane = tid & 63, wr = wid >> 2, wc = wid & 3, fr = lane & 15, fq = lane >> 4;
    int RA, CA; { const int b_ = tid * 16, st = b_ / 1024, sb = b_ % 1024, swz = sb ^ (((sb >> 9) & 1) << 5); RA = st * 16 + swz / 64; CA = (swz % 64) / 2; }
    const int aoff = ((wr * 64 + fr) >> 4) * 1024 + (((fr & 15) * 64 + fq * 16) ^ (((((fr & 15) * 64 + fq * 16) >> 9) & 1) << 5));
    const int n4 = tid & 63, kr = tid >> 6;
    int wcol; { const int a = n4 & 7, g32 = (n4 & 31) >> 3; wcol = Epi::PERM ? (32 * g32 + 8 * (a & 3) + 4 * (a >> 2)) : 4 * (n4 & 31); }
    const bool hi_half = n4 >= 32;
    unsigned bta[4];
    { const unsigned q = (lane & 15) >> 2, p = lane & 3, g = lane >> 4;
#pragma unroll
      for (int n = 0; n < 2; ++n)
#pragma unroll
          for (int t = 0; t < 2; ++t) { const unsigned row = 8 * g + 4 * t + q, ch = (unsigned)(32 * wc + 16 * n) / 8 + (p >> 1);
              bta[n * 2 + t] = 512u * row + 16u * (ch ^ (((row & 3u) << 2) | ((row >> 2) & 3u))) + 8u * (p & 1); } }
        const bf16_t* A = T1 ? c1.A : c0.A; const int lda = T1 ? c1.lda : c0.lda; const int* arow = T1 ? c1.arow : c0.arow; const int nst_all = (T1 ? c1.K : c0.K) / 32, nst = SPLIT ? nst_all / 2 : nst_all, kb = (SPLIT && kh > 0) ? nst : 0;
        const float* W0 = T1 ? c1.W0 : c0.W0; const float* W1 = T1 ? c1.W1 : c0.W1; const int ldn = T1 ? c1.ldn : c0.ldn; const size_t estride = T1 ? c1.estride : c0.estride; const int colstep = T1 ? c1.colstep : c0.colstep, NT = T1 ? c1.NT : c0.NT;
        if constexpr (T1) {
            if (tid == 0) { unsigned sp = 0; while (__hip_atomic_load(mcnt + cur.pm, __ATOMIC_RELAXED, __HIP_MEMORY_SCOPE_AGENT) < 4u) { __builtin_amdgcn_s_sleep(2); if (++sp > (1u << 22)) break; } }
            __syncthreads();
        }
        f32x4 acc[2][2][4][2];
#pragma unroll
        for (int x = 0; x < 2; ++x)
#pragma unroll
            for (int y = 0; y < 2; ++y)
#pragma unroll
                for (int m = 0; m < 4; ++m)
#pragma unroll
                    for (int n = 0; n < 2; ++n) acc[x][y][m][n] = (f32x4){0.f, 0.f, 0.f, 0.f};
        unsigned ao[2];
#pragma unroll
        for (int h = 0; h < 2; ++h) { const int r = cur.pm * BM + h * HALF + RA; int srow = r;
            if (arow) { srow = arow[r]; srow = ((unsigned)srow < 8192u) ? srow : 0; }
            ao[h] = ((unsigned)srow * (unsigned)lda + (unsigned)CA) * 2u + (unsigned)kb * 64u; }
        const int e = cur.pn / NT, j = cur.pn - e * NT;
        const float* wp = (hi_half ? W1 : W0) + (size_t)e * estride + (size_t)j * colstep + wcol + ((size_t)kr + (size_t)kb * 32) * ldn;
        const __amdgpu_buffer_rsrc_t hrs = __builtin_amdgcn_make_buffer_rsrc((void*)c1.A, 0, 0x7fffffff, 0x00020000);
        f32x4 wv0[4], wv1[4]; u32x4 av0[2], av1[2];
#define F_ISSUE(AV, WV, kt) do { if constexpr (T1) { _Pragma("unroll") for (int h = 0; h < 2; ++h) AV[h] = __builtin_amdgcn_raw_buffer_load_b128(hrs, (int)(ao[h] + (unsigned)(kt) * 64u), 0, 16); } \
            else { _Pragma("unroll") for (int h = 0; h < 2; ++h) AV[h] = *(const __attribute__((address_space(1))) u32x4*)((const char*)A + (ao[h] + (unsigned)(kt) * 64u)); } \
            _Pragma("unroll") for (int i = 0; i < 4; ++i) WV[i] = *(const __attribute__((address_space(1))) f32x4*)(wp + ((size_t)(kt) * 32 + 8 * i) * ldn); } while (0)
#define F_WRITE(AV, WV, b) do { _Pragma("unroll") for (int h = 0; h < 2; ++h) *(PG8_LAS u32x4*)(lds + F_SA(b, h) + tid * 16) = AV[h]; \
            _Pragma("unroll") for (int i = 0; i < 4; ++i) { typedef unsigned u32x2 __attribute__((ext_vector_type(2))); \
            *(PG8_LAS u32x2*)(lds + F_SB(b) + bimg(kr + 8 * i, 4 * n4)) = (u32x2){cvt_pk_bf16(WV[i][0], WV[i][1]), cvt_pk_bf16(WV[i][2], WV[i][3])}; } } while (0)
#define F_COMPUTE(b) do { const unsigned bb = (unsigned)(size_t)(lds + F_SB(b)); \
            _Pragma("unroll") for (int bj = 0; bj < 2; ++bj) { typedef short s16x4 __attribute__((ext_vector_type(4))); \
                const s16x4 d0 = __builtin_amdgcn_ds_read_tr16_b64_v4i16((PG8_LAS s16x4*)(size_t)(bb + bta[0] + 256 * bj)), d1 = __builtin_amdgcn_ds_read_tr16_b64_v4i16((PG8_LAS s16x4*)(size_t)(bb + bta[1] + 256 * bj)); \
                const s16x4 d2 = __builtin_amdgcn_ds_read_tr16_b64_v4i16((PG8_LAS s16x4*)(size_t)(bb + bta[2] + 256 * bj)), d3 = __builtin_amdgcn_ds_read_tr16_b64_v4i16((PG8_LAS s16x4*)(size_t)(bb + bta[3] + 256 * bj)); \
                const bf16x8 B0 = __builtin_shufflevector(d0, d1, 0, 1, 2, 3, 4, 5, 6, 7), B1 = __builtin_shufflevector(d2, d3, 0, 1, 2, 3, 4, 5, 6, 7); \
                _Pragma("unroll") for (int ai = 0; ai < 2; ++ai) { bf16x8 Af[4]; \
                    _Pragma("unroll") for (int m = 0; m < 4; ++m) Af[m] = *(const PG8_LAS bf16x8*)(lds + F_SA(b, ai) + aoff + m * 1024); \
                    __builtin_amdgcn_s_setprio(1); \
                    _Pragma("unroll") for (int m = 0; m < 4; ++m) { acc[ai][bj][m][0] = __builtin_amdgcn_mfma_f32_16x16x32_bf16(B0, Af[m], acc[ai][bj][m][0], 0, 0, 0); \
                                                                     acc[ai][bj][m][1] = __builtin_amdgcn_mfma_f32_16x16x32_bf16(B1, Af[m], acc[ai][bj][m][1], 0, 0, 0); } \
                    __builtin_amdgcn_s_setprio(0); } } } while (0)
#define F_SYNC() do { asm volatile("s_waitcnt lgkmcnt(0)" ::: "memory"); __builtin_amdgcn_s_barrier(); } while (0)
        F_ISSUE(av0, wv0, 0); F_ISSUE(av1, wv1, 1);
        F_WRITE(av0, wv0, 0);
        F_SYNC();
        for (int t = 0; t < nst; t += 2) {
            F_ISSUE(av0, wv0, (t + 2 < nst) ? t + 2 : nst - 1);
            __builtin_amdgcn_sched_barrier(0);
            F_COMPUTE(0);
            __builtin_amdgcn_sched_barrier(0);
            F_WRITE(av1, wv1, 1);
            asm volatile("s_waitcnt lgkmcnt(0)" ::: "memory"); __builtin_amdgcn_s_barrier();
            F_ISSUE(av1, wv1, (t + 3 < nst) ? t + 3 : nst - 1);
            __builtin_amdgcn_sched_barrier(0);
            F_COMPUTE(1);
            __builtin_amdgcn_sched_barrier(0);
            F_WRITE(av0, wv0, 0);
            asm volatile("s_waitcnt lgkmcnt(0)" ::: "memory"); __builtin_amdgcn_s_barrier();
        }
        if constexpr (SPLIT) {
            const unsigned xo = (unsigned)tid * 16u;
            const __amdgpu_buffer_rsrc_t xrs = __builtin_amdgcn_make_buffer_rsrc((void*)(xbuf + (size_t)ub * 1048576), 0, 1048576, 0x00020000);
            const int hb = kh * 524288;
#pragma unroll
            for (int x = 0; x < 2; ++x)
#pragma unroll
                for (int y = 0; y < 2; ++y)
#pragma unroll
                    for (int m = 0; m < 4; ++m)
#pragma unroll
                        for (int n = 0; n < 2; ++n) __builtin_amdgcn_raw_buffer_store_b128(__builtin_bit_cast(u32x4, acc[x][y][m][n]), xrs, (int)xo, hb + (((x * 2 + y) * 4 + m) * 2 + n) * 8192, 16);
            asm volatile("s_waitcnt vmcnt(0)" ::: "memory"); __syncthreads();
            if (tid == 0) __hip_atomic_fetch_add(xcnt + ub, 1u, __ATOMIC_RELAXED, __HIP_MEMORY_SCOPE_AGENT);
            if (kh == 1) {
                if (tid == 0) { unsigned sp = 0; while (__hip_atomic_load(xcnt + ub, __ATOMIC_RELAXED, __HIP_MEMORY_SCOPE_AGENT) < 2u) { __builtin_amdgcn_s_sleep(2); if (++sp > (1u << 22)) break; } }
                __syncthreads();
                const int row0 = cur.pm * BM + wr * 64 + fr, col0 = (cur.pn & 3) * 128 + wc * 32 + 8 * fq;
#pragma unroll 1
                for (int am = 0; am < 8; ++am) { const int ai = am >> 2, m = am & 3;
                    f32x4 pa[2][2], pb[2][2];
#pragma unroll
                    for (int n = 0; n < 2; ++n)
#pragma unroll
                        for (int hf = 0; hf < 2; ++hf) { pa[n][hf] = __builtin_bit_cast(f32x4, __builtin_amdgcn_raw_buffer_load_b128(xrs, (int)xo, hf * 524288 + (((ai * 2 + 0) * 4 + m) * 2 + n) * 8192, 16));
                                                          pb[n][hf] = __builtin_bit_cast(f32x4, __builtin_amdgcn_raw_buffer_load_b128(xrs, (int)xo, hf * 524288 + (((ai * 2 + 1) * 4 + m) * 2 + n) * 8192, 16)); }
                    float h[8];
#pragma unroll
                    for (int n = 0; n < 2; ++n)
#pragma unroll
                        for (int i = 0; i < 4; ++i) { const float ga = pa[n][0][i] + pa[n][1][i], gb = pb[n][0][i] + pb[n][1][i]; h[n * 4 + i] = ga * __builtin_amdgcn_rcpf(1.f + __builtin_amdgcn_exp2f(-1.4426950408889634f * ga)) * gb; }
                    u32x4 w; w.x = cvt_pk_bf16(h[0], h[1]); w.y = cvt_pk_bf16(h[2], h[3]); w.z = cvt_pk_bf16(h[4], h[5]); w.w = cvt_pk_bf16(h[6], h[7]);
                    bf16_t* rowp = EA.H + (size_t)(row0 + ai * HALF + m * 16) * 512 + col0;
                    asm volatile("global_store_dwordx4 %0, %1, off sc1\n\ts_nop 1" :: "v"(rowp), "v"(w) : "memory"); }
                asm volatile("s_waitcnt vmcnt(0)" ::: "memory"); __syncthreads();
                if (tid == 0) __hip_atomic_fetch_add(mcnt + cur.pm, 1u, __ATOMIC_RELAXED, __HIP_MEMORY_SCOPE_AGENT); }
        } else if constexpr (!T1) {
            EA(acc, cur, wr, wc, fr, fq);
            asm volatile("s_waitcnt vmcnt(0)" ::: "memory"); __syncthreads();
            if (tid == 0) __hip_atomic_fetch_add(mcnt + cur.pm, 1u, __ATOMIC_RELAXED, __HIP_MEMORY_SCOPE_AGENT); }
        else EB(acc, cur, wr, wc, fr, fq);
        ++ui;
        if (!S.next(ui, cur, type, kh, ub)) return false;
        F_UNIFORM();
    }
#undef F_UNIFORM
#undef F_SA
#undef F_SB
#undef F_ISSUE
#undef F_WRITE
#undef F_COMPUTE
#undef F_SYNC
}
template <class EpiA, class EpiB>
__device__ __forceinline__ void gemm_moe_fused(PG8_LAS unsigned char* lds, const MoeCfg c0, const MoeCfg c1, unsigned* mcnt, unsigned char* xbuf, unsigned* xcnt, const FusedOrder& S, const EpiA& EA, const EpiB& EB) {
    Unit cur; int ui = 0, type = 0, kh = -1, ub = 0;
    if (!S.next(0, cur, type, kh, ub)) return;
    cur.pm = __builtin_amdgcn_readfirstlane(cur.pm); cur.pn = __builtin_amdgcn_readfirstlane(cur.pn); type = __builtin_amdgcn_readfirstlane(type); kh = __builtin_amdgcn_readfirstlane(kh); ub = __builtin_amdgcn_readfirstlane(ub);
    if (!moe_run<0, EpiA, EpiB>(lds, c0, c1, mcnt, xbuf, xcnt, S, EA, EB, ui, cur, type, kh, ub)) return;
    if (!moe_run<1, EpiA, EpiB>(lds, c0, c1, mcnt, xbuf, xcnt, S, EA, EB, ui, cur, type, kh, ub)) return;
    (void)moe_run<2, EpiA, EpiB>(lds, c0, c1, mcnt, xbuf, xcnt, S, EA, EB, ui, cur, type, kh, ub);
}
}
constexpr int D = 2048, SEQ = 4096, NTOK = 8192, CTXL = 256, NCTX = 512, MROWS = NTOK + NCTX;
constexpr int MIXW = 7168;
constexpr int C_Q = 0, C_K = 1024, C_V = 1536, C_HQ = 2048, C_FF = 3072, C_FB = 4096, C_HI = 5120, C_HG = 6144;
constexpr int NEXP = 32, FF = 512;
constexpr float ALPHA = 1.41421356237309515f, LN_EPS = 1e-5f, NORM_EPS = 1e-6f;
constexpr int NWAVES = 8, NTHR = 512;
constexpr int XEROWS = 2 * NTOK + NEXP * 256;
constexpr size_t MiB = 1u << 20;
constexpr size_t WS_CTL = 0, CTL_ZERO_BYTES = 1 * MiB;
constexpr size_t WS_SMALL = 1 * MiB;
constexpr size_t WS_WIN = 4 * MiB;
constexpr size_t WS_WOUT = WS_WIN + (size_t)MIXW * D * 2;
constexpr size_t WS_WPIN = WS_WOUT + (size_t)D * D * 2;
constexpr size_t WS_WPOUT = WS_WPIN + (size_t)D * D * 2;
constexpr size_t WS_WGRP = WS_WPOUT + (size_t)D * D * 2;
constexpr size_t WS_W13 = WS_WGRP + (size_t)4 * 512 * 512 * 2;
constexpr size_t WS_W16 = WS_W13;
constexpr size_t WS_WFOLD = WS_W13 + 1 * MiB;
constexpr size_t WS_HALO = WS_W13 + 16 * MiB;
constexpr size_t WS_XBUF = WS_W13 + 32 * MiB;
constexpr size_t WS_W2 = WS_W13 + (size_t)2 * NEXP * 1024 * D * 2;
constexpr size_t WS_REGA = WS_W2 + (size_t)2 * NEXP * D * FF * 2;
constexpr size_t REGA_BYTES = (size_t)MROWS * MIXW * 2;
constexpr size_t WS_REGB = WS_REGA + REGA_BYTES;
constexpr size_t REGB_BYTES = (size_t)XEROWS * D * 2;
constexpr size_t WS_HX = WS_REGB + REGB_BYTES;
constexpr size_t WS_CAT = WS_HX + (size_t)MROWS * D * 2;
constexpr size_t WS_H = WS_CAT + (size_t)NTOK * D * 2;
constexpr size_t WS_YX = WS_H + (size_t)XEROWS * FF * 2;
constexpr size_t WS_X1 = WS_YX + (size_t)NTOK * D * 4;
constexpr size_t WS_X2 = WS_X1 + (size_t)NTOK * D * 4;
constexpr size_t WS_TOK = WS_X2 + (size_t)NTOK * D * 4;
constexpr size_t WS_END = WS_TOK + (size_t)NTOK * D * 2;
static_assert(WS_XBUF + (size_t)248 * 1048576 <= WS_REGA, "xbuf");
static_assert((size_t)XEROWS * D * 2 <= REGA_BYTES && (size_t)3 * NTOK * D * 2 <= REGA_BYTES && (size_t)2 * NTOK * 1024 * 4 <= REGB_BYTES, "aliases");
constexpr int CW_TMO = 0, CW_CNT = 64, CW_BAR = 4096, CW_MCNT = 200000  , CW_GVQ = 203584  , CW_HCNT = 203136  , CW_XCNT = 202048  , CW_INARR = 201024  ;
constexpr int SM_MOD = 0;
constexpr int SM_MC = SM_MOD + 2 * 2 * 6 * D;
constexpr int SM_LB = SM_MC + 6 * D;
constexpr int SM_TOKE = SM_LB + 2 * 1024;
constexpr int SM_TOKR = SM_TOKE + 2 * NTOK;
constexpr int SM_TOKG = SM_TOKR + 2 * NTOK;
constexpr int SM_TOKS = SM_TOKG + 2 * NTOK;
constexpr int SM_BCNT = SM_TOKS + 2 * NTOK;
constexpr int SM_SLOTTOK = SM_BCNT + 2 * 256 * 32;
constexpr int SM_END = SM_SLOTTOK + XEROWS;
static_assert((size_t)SM_END * 4 <= 3 * MiB, "small");
constexpr int RING_BYTES = 131072, LDS_CTLB = 162816  , LDS_TAB = LDS_CTLB  , LDS_MISC = LDS_CTLB + 512, LDS_BYTES = 163840;

#define GAS __attribute__((address_space(1)))
#define LAS __attribute__((address_space(3)))
typedef unsigned short bf16;
typedef unsigned v4u __attribute__((ext_vector_type(4)));
typedef unsigned v2u __attribute__((ext_vector_type(2)));
typedef float f32x4 __attribute__((ext_vector_type(4)));
typedef float f32x2v __attribute__((ext_vector_type(2)));
#define LDS_WAIT() asm volatile("s_waitcnt lgkmcnt(0)" ::: "memory")
#define VM_WAIT() asm volatile("s_waitcnt vmcnt(0)" ::: "memory")
__device__ __forceinline__ unsigned f2bf(float f) { unsigned u = __builtin_bit_cast(unsigned, f); return (u + 0x7fffu + ((u >> 16) & 1u)) >> 16; }
__device__ __forceinline__ unsigned pk2(float lo, float hi) { return f2bf(lo) | (f2bf(hi) << 16); }
__device__ __forceinline__ float bf2f(unsigned h) { return __builtin_bit_cast(float, h << 16); }
__device__ __forceinline__ float bflo(unsigned w) { return __builtin_bit_cast(float, w << 16); }
__device__ __forceinline__ float bfhi(unsigned w) { return __builtin_bit_cast(float, w & 0xffff0000u); }
__device__ __forceinline__ float sigmoid_f(float x) { return 1.f / (1.f + expf(-x)); }
__device__ __forceinline__ float silu_f(float x) { return x / (1.f + expf(-x)); }
__device__ __forceinline__ float fsigmoid(float x) { return __builtin_amdgcn_rcpf(1.f + __builtin_amdgcn_exp2f(-1.4426950408889634f * x)); }
__device__ __forceinline__ float fsilu(float x) { return x * fsigmoid(x); }
__device__ __forceinline__ float wave_sum(float v) {
    v += __builtin_bit_cast(float, __builtin_amdgcn_update_dpp(0, __builtin_bit_cast(int, v), 0xB1, 0xf, 0xf, true));
    v += __builtin_bit_cast(float, __builtin_amdgcn_update_dpp(0, __builtin_bit_cast(int, v), 0x4E, 0xf, 0xf, true));
    v += __builtin_bit_cast(float, __builtin_amdgcn_update_dpp(0, __builtin_bit_cast(int, v), 0x141, 0xf, 0xf, true));
    v += __builtin_bit_cast(float, __builtin_amdgcn_update_dpp(0, __builtin_bit_cast(int, v), 0x140, 0xf, 0xf, true));
    v += __builtin_bit_cast(float, __builtin_amdgcn_update_dpp(0, __builtin_bit_cast(int, v), 0x142, 0xa, 0xf, false));
    v += __builtin_bit_cast(float, __builtin_amdgcn_update_dpp(0, __builtin_bit_cast(int, v), 0x143, 0xc, 0xf, false));
    return __builtin_bit_cast(float, __builtin_amdgcn_readlane(__builtin_bit_cast(int, v), 63));
}
#define XB_TMO      128
#define XB_XCNT(j)  (256  + 64 * (j))
#define XB_XSUB(j)  (1280 + 64 * (j))
#define XB_XGEN(j)  (2304 + 64 * (j))
#define XB_TOP      3328
#define XB_TOPGEN   3392
#define XCD_BAR_WORDS 3456
#define XB_SPIN_CAP (1u << 18)

__device__ __forceinline__ unsigned xb_ld(unsigned* p)              { return __hip_atomic_load(p, __ATOMIC_RELAXED, __HIP_MEMORY_SCOPE_AGENT); }
__device__ __forceinline__ unsigned xb_add(unsigned* p, unsigned v) { return __hip_atomic_fetch_add(p, v, __ATOMIC_RELAXED, __HIP_MEMORY_SCOPE_AGENT); }
__device__ __forceinline__ unsigned xb_xcc_id() { return (unsigned)__builtin_amdgcn_s_getreg((3 << 11) | 20) & 0xFu; }
#define XB_SPIN(cond, bar) do { unsigned _sp = 0; while (cond) { __builtin_amdgcn_s_sleep(1); \
    if ((++_sp & 255u) == 0u) { if (xb_ld(&(bar)[XB_TMO])) break; if (_sp > XB_SPIN_CAP) { atomicAdd(&(bar)[XB_TMO], 1u); break; } } } } while (0)

struct XcdBarrier {
    unsigned* bar; unsigned x;
    volatile LAS unsigned* st;
};

__device__ __forceinline__ XcdBarrier xcd_barrier_post(unsigned* bar, volatile LAS unsigned* st) {
    XcdBarrier b; b.bar = bar; b.x = xb_xcc_id(); b.st = st;
    if (threadIdx.x == 0) (void)xb_add(&bar[XB_XCNT(b.x)], 1u);
    return b;
}
__device__ __forceinline__ void xcd_barrier_complete(unsigned* bar, unsigned x, unsigned& nloc, unsigned& nx) {
    const unsigned G = gridDim.x * gridDim.y * gridDim.z;
    unsigned sum, cnt, mine, sp = 0u;
    for (;;) {
        sum = 0u; cnt = 0u; mine = 0u;
#pragma unroll
        for (unsigned j = 0; j < 16; ++j) { const unsigned c = xb_ld(&bar[XB_XCNT(j)]); sum += c; cnt += (c > 0u) ? 1u : 0u; mine = (j == x) ? c : mine; }
        if (sum == G) break;
        __builtin_amdgcn_s_sleep(1);
        if ((++sp & 255u) == 0u) { if (xb_ld(&bar[XB_TMO])) break; if (sp > XB_SPIN_CAP) { atomicAdd(&bar[XB_TMO], 1u); break; } }
    }
    nloc = mine > 0u ? mine : 1u; nx = cnt > 0u ? cnt : 1u;
}

__device__ __forceinline__ void xcd_barrier(const XcdBarrier& b) {
    asm volatile("s_waitcnt vmcnt(0)" ::: "memory");
    __syncthreads();
    if (threadIdx.x == 0) {
        unsigned* bar = b.bar;
        __builtin_amdgcn_s_waitcnt(0);
        unsigned nloc = b.st[0], nx = b.st[1];
        if (nloc == 0u) { xcd_barrier_complete(bar, b.x, nloc, nx); b.st[0] = nloc; b.st[1] = nx; }
        const unsigned old = xb_add(&bar[XB_XSUB(b.x)], 1u);
        const unsigned gen = old / nloc;
        if (old + 1u == (gen + 1u) * nloc) {
            __builtin_amdgcn_fence(__ATOMIC_RELEASE, "agent");
            asm volatile("s_waitcnt vmcnt(0)" ::: "memory");
            const unsigned og = xb_add(&bar[XB_TOP], 1u);
            const unsigned tg = og / nx;
            if (og + 1u == (tg + 1u) * nx) xb_add(&bar[XB_TOPGEN], 1u);
            else XB_SPIN(xb_ld(&bar[XB_TOPGEN]) == tg, bar);
            __builtin_amdgcn_fence(__ATOMIC_ACQUIRE, "agent");
            xb_add(&bar[XB_XGEN(b.x)], 1u);
            asm volatile("s_waitcnt vmcnt(0)" ::: "memory");
        } else {
            XB_SPIN(xb_ld(&bar[XB_XGEN(b.x)]) == gen, bar);
            __builtin_amdgcn_fence(__ATOMIC_ACQUIRE, "agent");
            asm volatile("s_waitcnt vmcnt(0)" ::: "memory");
        }
    }
    __syncthreads();
}
struct Args { const float* in[24]; float* out; unsigned char* ws; int ph_lo, ph_hi; };
struct Ctx {
    LAS unsigned char* lds; int tid, lane, wave, vcu, G;
};

__device__ __forceinline__ void tr_item(const float* W, int K, int N, bf16* WT, int k0, int n0, int drow0, LAS float* scr, int lane, bool rperm = false) {
    const int kr = lane >> 4, n4 = (lane & 15) * 4;
#pragma unroll 8
    for (int i = 0; i < 16; ++i) { const int kk = 4 * i + kr; const f32x4 v = *(const GAS f32x4*)(W + (size_t)(k0 + kk) * N + n0 + n4);
        LAS float* s = scr + kk * 65 + n4; s[0] = v[0]; s[1] = v[1]; s[2] = v[2]; s[3] = v[3]; }
    LDS_WAIT();
    const int c = lane & 7;
#pragma unroll
    for (int j = 0; j < 8; ++j) { const int n = (lane >> 3) + 8 * j, ns = rperm ? (4 * (n >> 3) + (n & 3) + 32 * ((n >> 2) & 1)) : n; const LAS float* s = scr + (8 * c) * 65 + ns;
        v4u o; o.x = pk2(s[0 * 65], s[1 * 65]); o.y = pk2(s[2 * 65], s[3 * 65]); o.z = pk2(s[4 * 65], s[5 * 65]); o.w = pk2(s[6 * 65], s[7 * 65]);
        *(GAS v4u*)(WT + (size_t)(drow0 + n) * K + k0 + 8 * c) = o; }
    LDS_WAIT();
}
__device__ __forceinline__ void p0_convert(const Ctx& F, const Args& a, int me, int nb, bool late, int gemv_wgs = 0) {
    unsigned char* ws = a.ws;
    LAS float* scr = (LAS float*)(F.lds + F.wave * 16640);
    const int gw = me * NWAVES + F.wave, NGW = nb * NWAVES;
    constexpr int I_IN = 32 * (MIXW / 64), I_SQ = 32 * 32, I_GRP = 4 * 64, I_MOE = 64 * 768;
    constexpr int NITEMS = I_IN + 1 * I_SQ + I_GRP;
    if (me < 0 || me >= nb) return;
    if (late) { for (int r = gw; r < I_SQ; r += NGW) tr_item(a.in[13], D, D, (bf16*)(ws + WS_WPIN), 64 * (r / 32), 64 * (r % 32), 64 * (r % 32), scr, F.lane); return; }
    if (gemv_wgs < 0) {
        for (int r = gw; r < I_SQ; r += NGW) tr_item(a.in[12], D, D, (bf16*)(ws + WS_WOUT), 64 * (r / 32), 64 * (r % 32), 64 * (r % 32), scr, F.lane); return; }
    const int gb = gemv_wgs < nb ? gemv_wgs : nb, shares = me < gb ? 1 : 2, vbase = me < gb ? me * NWAVES : gb * NWAVES + (me - gb) * 2 * NWAVES, vtot = gb * NWAVES + (nb - gb) * 2 * NWAVES;
    for (int sh = 0; sh < shares; ++sh)
    for (int it = vbase + sh * NWAVES + F.wave; it < NITEMS; it += vtot) {
        int r = it;
        if (r < I_IN) { const int nb = MIXW / 64; tr_item(a.in[8], D, MIXW, (bf16*)(ws + WS_WIN), 64 * (r / nb), 64 * (r % nb), 64 * (r % nb), scr, F.lane, 64 * (r % nb) < C_V); continue; } r -= I_IN;
        if (r < I_SQ) { tr_item(a.in[16], D, D, (bf16*)(ws + WS_WPOUT), 64 * (r / 32), 64 * (r % 32), 64 * (r % 32), scr, F.lane); continue; } r -= I_SQ;
        if (r < I_GRP) { const int g = r / 64, ii = r % 64, c0 = 64 * (ii / 8), j0 = 64 * (ii % 8) + 4 * (F.lane & 15);
            const f32x4 sc = *(const GAS f32x4*)(a.in[15] + 512 * g + j0);
#pragma unroll 4
            for (int i = 0; i < 16; ++i) { const size_t e = ((size_t)g * 512 + c0 + 4 * i + (F.lane >> 4)) * 512 + j0; const f32x4 v = *(const GAS f32x4*)(a.in[14] + e) * sc;
                *(GAS v2u*)((bf16*)(ws + WS_WGRP) + e) = (v2u){pk2(v[0], v[1]), pk2(v[2], v[3])}; }
            continue; } r -= I_GRP;
        { const int le = r / 768, q = r % 768, which = q / 256, ii = q % 256;
          if (which < 2) { const int n0 = 64 * (ii % 8), drow0 = 256 * (n0 / 128) + (n0 % 128) + (which ? 128 : 0);
              tr_item(a.in[which ? 22 : 21] + (size_t)le * D * FF, D, FF, (bf16*)(ws + WS_W13) + (size_t)le * 1024 * D, 64 * (ii / 8), n0, drow0, scr, F.lane); }
          else tr_item(a.in[23] + (size_t)le * FF * D, FF, D, (bf16*)(ws + WS_W2) + (size_t)le * D * FF, 64 * (ii / 32), 64 * (ii % 32), 64 * (ii % 32), scr, F.lane); }
    }
}
__device__ __forceinline__ void p0_router_frags(const Ctx& F, const Args& a) {
    typedef _Float16 f16x8 __attribute__((ext_vector_type(8)));
    GAS f16x8* out = (GAS f16x8*)(a.ws + WS_W16);
    for (int i = F.vcu * NTHR + F.tid; i < 2 * 128 * 2 * 64; i += F.G * NTHR) {
        const int lane = i & 63, nt = (i >> 6) & 1, ks = (i >> 7) & 127, layer = i >> 14, col = 32 * nt + (lane & 31), k0 = 16 * ks + 8 * (lane >> 5);
        f16x8 v;
#pragma unroll
        for (int j = 0; j < 8; ++j) { float x = 0.f; if (col < 32) x = a.in[19][((size_t)layer * D + k0 + j) * 32 + col]; else if (col < 36) x = a.in[17][((size_t)layer * D + k0 + j) * 4 + (col - 32)]; v[j] = (_Float16)x; }
        out[i] = v;
    }
}
__device__ __forceinline__ void p0_mod(const Ctx& F, const Args& a, int u_lo, int u_hi, int me, int nb, bool with_lb, unsigned* queue = nullptr) {
    float* sm = (float*)(a.ws + WS_SMALL);
    LAS float* sv = (LAS float*)F.lds;
    LAS float* part = sv + 3 * D;
    for (int k = F.tid; k < D; k += NTHR) { sv[k] = silu_f(a.in[1][k]); sv[D + k] = silu_f(a.in[1][D + k]); sv[2 * D + k] = silu_f(a.in[3][k]); }
    __syncthreads();
    if (me < 0 || me >= nb) return;
    LAS int* qslot = (LAS int*)(part + 32 * 192);
    for (int u = u_lo + me; ; u += nb) {
        if (queue) { __syncthreads(); if (F.tid == 0) *qslot = (int)__hip_atomic_fetch_add(queue, 1u, __ATOMIC_RELAXED, __HIP_MEMORY_SCOPE_AGENT); __syncthreads(); u = u_lo + *qslot; }
        if (u >= u_hi) break;
        const int l = u / 192, col0 = (u % 192) * 64;
        const int sub = F.lane >> 4, q = F.lane & 15, slot = F.wave * 4 + sub;
        f32x4 a0 = {0.f, 0.f, 0.f, 0.f}, a1 = a0, a2 = a0;
        { const float* w = a.in[4] + (size_t)l * D * 6 * D + col0 + 4 * q;
#pragma unroll 8
            for (int r = slot; r < D; r += 32) { const f32x4 v = *(const GAS f32x4*)(w + (size_t)r * 6 * D); a0 += v * sv[r]; a1 += v * sv[D + r]; a2 += v * sv[2 * D + r]; }
            LAS float* p = part + slot * 192 + 4 * q;
            *(LAS f32x4*)p = a0; *(LAS f32x4*)(p + 64) = a1; *(LAS f32x4*)(p + 128) = a2;
        }
        __syncthreads();
        if (F.tid < 192) { float s = 0.f;
#pragma unroll
            for (int i = 0; i < 32; ++i) s += part[i * 192 + F.tid];
            const int v = F.tid >> 6, j = col0 + (F.tid & 63); s += a.in[5][l * 6 * D + j];
            if (v < 2) sm[SM_MOD + (l * 2 + v) * 6 * D + j] = s; else if (l == 0) sm[SM_MC + j] = s; }
        __syncthreads();
    }
    if (with_lb) for (int i = me * NTHR + F.tid; i < 2048; i += nb * NTHR) {
        const int dir = i >> 10, k = i & 1023; const float* hl = a.in[10];
        const float x0 = hl[(dir * 3 + 0) * 1024 + k], x1 = hl[(dir * 3 + 1) * 1024 + k], x2 = hl[(dir * 3 + 2) * 1024 + k];
        const float m = fmaxf(x0, fmaxf(x1, x2)), e0 = expf(x0 - m), e1 = expf(x1 - m), e2 = expf(x2 - m);
        sm[SM_LB + i] = e0 / (e0 + e1 + e2);
    }
}
__device__ __forceinline__ void p1_modulate(const Ctx& F, const Args& a) {
    const float* sm = (const float*)(a.ws + WS_SMALL); bf16* HX = (bf16*)(a.ws + WS_HX);
#pragma unroll 4
    for (int i = F.vcu * NTHR + F.tid; i < MROWS * (D / 8); i += F.G * NTHR) {
        const int t = i >> 8, d = (i & 255) * 8;
        const float* src; const float* sh; const float* sc;
        if (t < NTOK) { src = a.in[0] + (size_t)t * D + d; sh = sm + SM_MOD + (t / SEQ) * 6 * D + d; sc = sh + D; }
        else { src = a.in[2] + (size_t)(t - NTOK) * D + d; sh = sm + SM_MC + d; sc = sh + D; }
        const f32x4 x0 = *(const GAS f32x4*)src, x1 = *(const GAS f32x4*)(src + 4), h0 = *(const GAS f32x4*)sh, h1 = *(const GAS f32x4*)(sh + 4), c0 = *(const GAS f32x4*)sc, c1 = *(const GAS f32x4*)(sc + 4);
        const f32x4 y0 = x0 * (c0 + 1.f) + h0, y1 = x1 * (c1 + 1.f) + h1;
        v4u o; o.x = pk2(y0[0], y0[1]); o.y = pk2(y0[2], y0[3]); o.z = pk2(y1[0], y1[1]); o.w = pk2(y1[2], y1[3]);
        *(GAS v4u*)(HX + (size_t)t * D + d) = o;
    }
}
typedef short bf16x8_t __attribute__((ext_vector_type(8)));
typedef float f32x16 __attribute__((ext_vector_type(16)));
typedef unsigned short u16x4_t __attribute__((ext_vector_type(4)));
__device__ __forceinline__ unsigned offb(unsigned row, unsigned ch) { return 256u * row + 16u * (ch ^ (((row & 3u) << 2) | ((row >> 2) & 3u))); }
__device__ __forceinline__ unsigned cvtpk(float lo, float hi) { unsigned r; asm volatile("v_cvt_pk_bf16_f32 %0, %1, %2" : "=v"(r) : "v"(lo), "v"(hi)); return r; }
#define TR8(d0, d1, d2, d3, d4, d5, d6, d7, a0, a1, a2, a3, a4, a5, a6, a7, OFF) \
    asm volatile("ds_read_b64_tr_b16 %0, %8 offset:" #OFF "\n\tds_read_b64_tr_b16 %1, %9 offset:" #OFF "\n\tds_read_b64_tr_b16 %2, %10 offset:" #OFF "\n\tds_read_b64_tr_b16 %3, %11 offset:" #OFF "\n\t" \
                 "ds_read_b64_tr_b16 %4, %12 offset:" #OFF "\n\tds_read_b64_tr_b16 %5, %13 offset:" #OFF "\n\tds_read_b64_tr_b16 %6, %14 offset:" #OFF "\n\tds_read_b64_tr_b16 %7, %15 offset:" #OFF "\n\ts_waitcnt lgkmcnt(0)" \
                 : "=&v"(d0), "=&v"(d1), "=&v"(d2), "=&v"(d3), "=&v"(d4), "=&v"(d5), "=&v"(d6), "=&v"(d7) : "v"(a0), "v"(a1), "v"(a2), "v"(a3), "v"(a4), "v"(a5), "v"(a6), "v"(a7) : "memory")
__device__ __forceinline__ bf16x8_t cat4(u16x4_t lo, u16x4_t hi) { bf16x8_t r; r[0] = (short)lo[0]; r[1] = (short)lo[1]; r[2] = (short)lo[2]; r[3] = (short)lo[3]; r[4] = (short)hi[0]; r[5] = (short)hi[1]; r[6] = (short)hi[2]; r[7] = (short)hi[3]; return r; }

typedef short s16x4_t __attribute__((ext_vector_type(4)));
__device__ __forceinline__ bf16x8_t trd2(unsigned a0, unsigned a1) {
    const s16x4_t lo = __builtin_amdgcn_ds_read_tr16_b64_v4i16((LAS s16x4_t*)(size_t)a0), hi = __builtin_amdgcn_ds_read_tr16_b64_v4i16((LAS s16x4_t*)(size_t)a1);
    return __builtin_shufflevector(lo, hi, 0, 1, 2, 3, 4, 5, 6, 7);
}
__device__ __forceinline__ void p4_attn_mfma(const Ctx& F, const Args& a) {
    const bf16* P = (const bf16*)(a.ws + WS_REGA); const bf16* PC = P + (size_t)NTOK * MIXW; bf16* CAT = (bf16*)(a.ws + WS_CAT);
    LAS unsigned char* Kl = F.lds; LAS unsigned char* Vl = F.lds + 16384;
    const int w = F.wave, l = F.lane, qi = l & 31, h = l >> 5, tid = F.tid;
    constexpr float CS = 0.08838834764831845f * 1.4426950408889634f;
    unsigned ka[8];
#pragma unroll
    for (int ks = 0; ks < 8; ++ks) ka[ks] = offb(qi, 2 * ks + h);
    unsigned va[8];
    { const unsigned blk = (l >> 4) & 1, q4 = (l & 15) >> 2, p = l & 3;
#pragma unroll
      for (int c = 0; c < 4; ++c)
#pragma unroll
          for (int t = 0; t < 2; ++t) va[c * 2 + t] = (unsigned)(size_t)Vl + offb(8 * t + 4 * h + q4, 4 * c + 2 * blk + (p >> 1)) + 8 * (p & 1); }
    for (int u = F.vcu; u < 256; u += F.G) {
        const int kvh = u & 3, qb = (u >> 2) & 31, b = u >> 7;
        const int head = kvh * 2 + (w >> 2), q0 = qb * 128 + 32 * (w & 3);
        bf16x8_t Q[8];
        { const bf16* qrow = P + (size_t)(b * SEQ + q0 + qi) * MIXW + C_Q + head * 128 + 8 * h;
#pragma unroll
          for (int ks = 0; ks < 8; ++ks) Q[ks] = *(const GAS bf16x8_t*)(qrow + 16 * ks); }
        const float sink2 = a.in[9][head] * 1.4426950408889634f;
        float m = sink2, lsum = 1.f;
        f32x16 O[4];
#pragma unroll
        for (int c = 0; c < 4; ++c)
#pragma unroll
            for (int r = 0; r < 16; ++r) O[c][r] = 0.f;
        const int kt_lo = (2 * qb - 2 < 0) ? 0 : 2 * qb - 2, kt_hi = (2 * qb + 4 > 64) ? 64 : 2 * qb + 4, nlat = kt_hi - kt_lo, ntile = nlat + 4;
        v4u kr[2], vr[2];
        auto src_row = [&](int ti, int row) -> const bf16* { return (ti < nlat) ? (P + (size_t)(b * SEQ + (kt_lo + ti) * 64 + row) * MIXW) : (PC + (size_t)(b * CTXL + (ti - nlat) * 64 + row) * MIXW); };
#pragma unroll
        for (int i = 0; i < 2; ++i) { const int n = tid + 512 * i; const bf16* r0 = src_row(0, n >> 4) + kvh * 128 + 8 * (n & 15); kr[i] = *(const GAS v4u*)(r0 + C_K); vr[i] = *(const GAS v4u*)(r0 + C_V); }
        for (int ti = 0; ti < ntile; ++ti) {
            __syncthreads();
#pragma unroll
            for (int i = 0; i < 2; ++i) { const int n = tid + 512 * i; const unsigned o = offb(n >> 4, n & 15); *(LAS v4u*)(Kl + o) = kr[i]; *(LAS v4u*)(Vl + o) = vr[i]; }
            __syncthreads();
            if (ti + 1 < ntile) {
#pragma unroll
                for (int i = 0; i < 2; ++i) { const int n = tid + 512 * i; const bf16* r0 = src_row(ti + 1, n >> 4) + kvh * 128 + 8 * (n & 15); kr[i] = *(const GAS v4u*)(r0 + C_K); vr[i] = *(const GAS v4u*)(r0 + C_V); }
            }
            f32x16 S0, S1;
#pragma unroll
            for (int r = 0; r < 16; ++r) { S0[r] = 0.f; S1[r] = 0.f; }
#pragma unroll
            for (int ks = 0; ks < 8; ++ks) {
                const bf16x8_t a0 = *(const LAS bf16x8_t*)(Kl + ka[ks]), a1 = *(const LAS bf16x8_t*)(Kl + ka[ks] + 8192);
                S0 = __builtin_amdgcn_mfma_f32_32x32x16_bf16(a0, Q[ks], S0, 0, 0, 0);
                S1 = __builtin_amdgcn_mfma_f32_32x32x16_bf16(a1, Q[ks], S1, 0, 0, 0);
            }
            const bool lat = ti < nlat; const int dbase = (q0 + qi) - ((kt_lo + ti) * 64 + 4 * h);
            float mx = -INFINITY;
#pragma unroll
            for (int r = 0; r < 16; ++r) {
                float t0 = S0[r] * CS, t1 = S1[r] * CS;
                if (lat) { const int d0 = dbase - ((r & 3) + 8 * (r >> 2)), d1 = d0 - 32; if ((unsigned)(d0 + 128) > 256u) t0 = -INFINITY; if ((unsigned)(d1 + 128) > 256u) t1 = -INFINITY; }
                S0[r] = t0; S1[r] = t1; mx = fmaxf(mx, fmaxf(t0, t1));
            }
            mx = fmaxf(mx, __shfl_xor(mx, 32));
            const float mn = fmaxf(m, mx), alpha = __builtin_amdgcn_exp2f(m - mn);
            float rs = 0.f;
#pragma unroll
            for (int r = 0; r < 16; ++r) { S0[r] = __builtin_amdgcn_exp2f(S0[r] - mn); S1[r] = __builtin_amdgcn_exp2f(S1[r] - mn); rs += S0[r] + S1[r]; }
            rs += __shfl_xor(rs, 32);
            lsum = lsum * alpha + rs; m = mn;
#pragma unroll
            for (int c = 0; c < 4; ++c)
#pragma unroll
                for (int r = 0; r < 16; ++r) O[c][r] *= alpha;
            bf16x8_t Pf[4];
#pragma unroll
            for (int s = 0; s < 2; ++s) {
                union { bf16x8_t v; unsigned u[4]; } x0, x1;
#pragma unroll
                for (int j = 0; j < 4; ++j) { x0.u[j] = cvtpk(S0[8 * s + 2 * j], S0[8 * s + 2 * j + 1]); x1.u[j] = cvtpk(S1[8 * s + 2 * j], S1[8 * s + 2 * j + 1]); }
                Pf[s] = x0.v; Pf[2 + s] = x1.v;
            }
#define ATT_PV(KK, OFF) do { \
                O[0] = __builtin_amdgcn_mfma_f32_32x32x16_bf16(trd2(va[0] + (OFF), va[1] + (OFF)), Pf[KK], O[0], 0, 0, 0); O[1] = __builtin_amdgcn_mfma_f32_32x32x16_bf16(trd2(va[2] + (OFF), va[3] + (OFF)), Pf[KK], O[1], 0, 0, 0); \
                O[2] = __builtin_amdgcn_mfma_f32_32x32x16_bf16(trd2(va[4] + (OFF), va[5] + (OFF)), Pf[KK], O[2], 0, 0, 0); O[3] = __builtin_amdgcn_mfma_f32_32x32x16_bf16(trd2(va[6] + (OFF), va[7] + (OFF)), Pf[KK], O[3], 0, 0, 0); } while (0)
            ATT_PV(0, 0); ATT_PV(1, 4096); ATT_PV(2, 8192); ATT_PV(3, 12288);
#undef ATT_PV
        }
        const float inv = 1.f / lsum;
        bf16* orow = CAT + (size_t)(b * SEQ + q0 + qi) * D + head * 128 + 4 * h;
#pragma unroll
        for (int c = 0; c < 4; ++c)
#pragma unroll
            for (int rr = 0; rr < 4; ++rr)
                *(GAS v2u*)(orow + 32 * c + 8 * rr) = (v2u){cvtpk(O[c][4 * rr] * inv, O[c][4 * rr + 1] * inv), cvtpk(O[c][4 * rr + 2] * inv, O[c][4 * rr + 3] * inv)};
    }
}
constexpr int HG_QP = 0, HG_KP = 16384, HG_VV = 32768, HG_SC = 49152, HG_EM = 58368, HG_EE = 58880, HG_T0 = 59392, HG_DIR = 61440;
constexpr size_t HG_LSZ = (size_t)128 * 128;
constexpr size_t WS_HGL = WS_X1, WS_HGG = WS_X1 + (size_t)2 * 16 * 17 * HG_LSZ * 4, WS_HGS = WS_YX;
static_assert(WS_HGG + (size_t)2 * 16 * 17 * 256 * 4 <= WS_X2 && (size_t)2 * 16 * 16 * HG_LSZ * 4 <= (size_t)NTOK * D * 4, "hgrn workspace");
#define TR2(d0, d1, a0, a1, OFF) asm volatile("ds_read_b64_tr_b16 %0, %2 offset:" #OFF "\n\tds_read_b64_tr_b16 %1, %3 offset:" #OFF "\n\ts_waitcnt lgkmcnt(0)" : "=&v"(d0), "=&v"(d1) : "v"(a0), "v"(a1) : "memory")

template <bool OUT> __device__ __forceinline__ void hg_unit(const Ctx& F, const Args& a, int b, int hh, int chunk  ) {
    const bf16* P = (const bf16*)(a.ws + WS_REGA); const float* sm = (const float*)(a.ws + WS_SMALL);
    const int dir = F.wave >> 2, wd = F.wave & 3, l = F.lane, qi = l & 31, h = l >> 5, tt = F.tid & 255, kch = tt & 127, half = tt >> 7;
    LAS unsigned char* Ld = F.lds + dir * HG_DIR;
    const GAS bf16* rows = (const GAS bf16*)((chunk < 16) ? (P + (size_t)(b * SEQ + chunk * 256) * MIXW) : (P + (size_t)(NTOK + b * CTXL) * MIXW));
    const int chain = b * 8 + hh;
    const float lbk = ((const GAS float*)sm)[SM_LB + dir * 1024 + hh * 128 + kch];
    f32x16 S[4];
    if (OUT) { const GAS float* s0 = (const GAS float*)(a.ws + WS_HGS) + ((size_t)(dir * 16 + chain) * 16 + chunk) * HG_LSZ + 32 * wd + qi;
#pragma unroll
        for (int kt = 0; kt < 4; ++kt)
#pragma unroll
            for (int r = 0; r < 16; ++r) S[kt][r] = s0[(size_t)(32 * kt + (r & 3) + 8 * (r >> 2) + 4 * h) * 128]; }
    else {
#pragma unroll
        for (int kt = 0; kt < 4; ++kt)
#pragma unroll
            for (int r = 0; r < 16; ++r) S[kt][r] = 0.f; }
    float gtot = 0.f;
    unsigned vta[2], kta[8];
    { const unsigned blk = (l >> 4) & 1, q4 = (l & 15) >> 2, p = l & 3;
#pragma unroll
      for (int t = 0; t < 2; ++t) { vta[t] = (unsigned)(size_t)(Ld + HG_VV) + offb(8 * h + 4 * t + q4, 4 * wd + 2 * blk + (p >> 1)) + 8 * (p & 1);
#pragma unroll
          for (int kt = 0; kt < 4; ++kt) kta[kt * 2 + t] = (unsigned)(size_t)(Ld + HG_KP) + offb(8 * h + 4 * t + q4, 4 * kt + 2 * blk + (p >> 1)) + 8 * (p & 1); } }
    v4u rk[4], rv[4], rq[4];
#pragma unroll
    for (int i = 0; i < 4; ++i) { const int n = tt + 256 * i, t = n >> 4, ch = n & 15, tok = dir ? 255 - t : t;
        const GAS bf16* rp = rows + (size_t)tok * MIXW + hh * 128 + 8 * ch;
        rk[i] = *(const GAS v4u*)(rp + (dir ? C_FB : C_FF)); rv[i] = *(const GAS v4u*)(rp + C_HI); if (OUT) rq[i] = *(const GAS v4u*)(rp + C_HQ); else rq[i] = rk[i]; }
#pragma unroll 1
    for (int sub = 0; sub < 4; ++sub) {
#pragma unroll
        for (int i = 0; i < 4; ++i) { const int n = tt + 256 * i, t = n >> 4, ch = n & 15; const unsigned o = offb(t, ch);
            *(LAS v4u*)(Ld + HG_KP + o) = rk[i]; *(LAS v4u*)(Ld + HG_VV + o) = rv[i]; if (OUT) *(LAS v4u*)(Ld + HG_QP + o) = rq[i]; }
        __syncthreads();
        if (sub < 3) {
#pragma unroll
            for (int i = 0; i < 4; ++i) { const int n = tt + 256 * i, t = n >> 4, ch = n & 15, p = 64 * (sub + 1) + t, tok = dir ? 255 - p : p;
                const GAS bf16* rp = rows + (size_t)tok * MIXW + hh * 128 + 8 * ch;
                rk[i] = *(const GAS v4u*)(rp + (dir ? C_FB : C_FF)); rv[i] = *(const GAS v4u*)(rp + C_HI); if (OUT) rq[i] = *(const GAS v4u*)(rp + C_HQ); }
        }
        { float prod = 1.f;
#pragma unroll 8
          for (int ii = 0; ii < 32; ++ii) { const int i = half ? ii : 31 - ii, t = 32 * half + i;
              const unsigned o = offb(t, kch >> 3) + 2 * (kch & 7);
              const float xl = bf2f(*(const LAS unsigned short*)(Ld + HG_KP + o)); const float f = lbk + (1.f - lbk) * fsigmoid(xl);
              float up, dn;
              if (half) { prod *= f; up = prod; dn = __builtin_amdgcn_rcpf(prod); } else { dn = prod; up = __builtin_amdgcn_rcpf(prod); prod *= f; }
              *(LAS unsigned short*)(Ld + HG_KP + o) = (unsigned short)f2bf((1.f - f) * dn);
              if (OUT) { const float q = bf2f(*(const LAS unsigned short*)(Ld + HG_QP + o)); *(LAS unsigned short*)(Ld + HG_QP + o) = (unsigned short)f2bf(q * up); } }
          *(LAS float*)(Ld + (half ? HG_EE : HG_EM) + 4 * kch) = prod; gtot += __logf(prod); }
        __syncthreads();
        if (OUT) {
            const int mt = wd >> 1, nt = wd & 1;
            f32x16 C;
#pragma unroll
            for (int r = 0; r < 16; ++r) C[r] = 0.f;
            if (!(mt == 0 && nt == 1)) {
#pragma unroll
                for (int ks = 0; ks < 8; ++ks) { const bf16x8_t af = *(const LAS bf16x8_t*)(Ld + HG_QP + offb(32 * mt + qi, 2 * ks + h)), bfv = *(const LAS bf16x8_t*)(Ld + HG_KP + offb(32 * nt + qi, 2 * ks + h));
                    C = __builtin_amdgcn_mfma_f32_32x32x16_bf16(af, bfv, C, 0, 0, 0); } }
            const int s = 32 * nt + qi;
#pragma unroll
            for (int r = 0; r < 16; ++r) { const int t = 32 * mt + (r & 3) + 8 * (r >> 2) + 4 * h; const float v = (s <= t) ? C[r] : 0.f;
                *(LAS unsigned short*)(Ld + HG_SC + t * 144 + 2 * s) = (unsigned short)f2bf(v); }
        }
#pragma unroll
        for (int kt = 0; kt < 4; ++kt)
#pragma unroll
            for (int rr = 0; rr < 4; ++rr) { const f32x4 e4 = *(const LAS f32x4*)(Ld + HG_EM + 4 * (32 * kt + 8 * rr + 4 * h));
#pragma unroll
                for (int j = 0; j < 4; ++j) S[kt][4 * rr + j] *= e4[j]; }
        if (OUT) __syncthreads();
        bf16x8_t Vf[4];
        Vf[0] = trd2(vta[0], vta[1]); Vf[1] = trd2(vta[0] + 4096, vta[1] + 4096); Vf[2] = trd2(vta[0] + 8192, vta[1] + 8192); Vf[3] = trd2(vta[0] + 12288, vta[1] + 12288);
        if (OUT) {
            f32x16 o0, o1;
#pragma unroll
            for (int r = 0; r < 16; ++r) { o0[r] = 0.f; o1[r] = 0.f; }
#pragma unroll
            for (int kt = 0; kt < 4; ++kt)
#pragma unroll
                for (int s2 = 0; s2 < 2; ++s2) {
                    union { bf16x8_t v; unsigned u[4]; } sb;
#pragma unroll
                    for (int j = 0; j < 4; ++j) sb.u[j] = cvtpk(S[kt][8 * s2 + 2 * j], S[kt][8 * s2 + 2 * j + 1]);
                    union { bf16x8_t v; v2u p[2]; } q0, q1;
                    q0.p[0] = *(const LAS v2u*)(Ld + HG_QP + offb(qi, 4 * kt + 2 * s2) + 8 * h); q0.p[1] = *(const LAS v2u*)(Ld + HG_QP + offb(qi, 4 * kt + 2 * s2 + 1) + 8 * h);
                    q1.p[0] = *(const LAS v2u*)(Ld + HG_QP + offb(32 + qi, 4 * kt + 2 * s2) + 8 * h); q1.p[1] = *(const LAS v2u*)(Ld + HG_QP + offb(32 + qi, 4 * kt + 2 * s2 + 1) + 8 * h);
                    o0 = __builtin_amdgcn_mfma_f32_32x32x16_bf16(q0.v, sb.v, o0, 0, 0, 0); o1 = __builtin_amdgcn_mfma_f32_32x32x16_bf16(q1.v, sb.v, o1, 0, 0, 0);
                }
#pragma unroll
            for (int ss = 0; ss < 4; ++ss) { const bf16x8_t a0 = *(const LAS bf16x8_t*)(Ld + HG_SC + qi * 144 + 32 * ss + 16 * h), a1 = *(const LAS bf16x8_t*)(Ld + HG_SC + (32 + qi) * 144 + 32 * ss + 16 * h);
                o0 = __builtin_amdgcn_mfma_f32_32x32x16_bf16(a0, Vf[ss], o0, 0, 0, 0); o1 = __builtin_amdgcn_mfma_f32_32x32x16_bf16(a1, Vf[ss], o1, 0, 0, 0); }
            GAS float* O = (GAS float*)(a.ws + WS_REGB) + (size_t)dir * NTOK * 1024 + (size_t)(b * SEQ + chunk * 256) * 1024 + hh * 128 + 32 * wd + qi;
#pragma unroll
            for (int r = 0; r < 16; ++r) { const int t = (r & 3) + 8 * (r >> 2) + 4 * h, p0 = 64 * sub + t, p1 = p0 + 32;
                O[(size_t)(dir ? 255 - p0 : p0) * 1024] = o0[r]; O[(size_t)(dir ? 255 - p1 : p1) * 1024] = o1[r]; }
        }
#define HG_UPD(SS, OFF) do { _Pragma("unroll") for (int kt = 0; kt < 4; ++kt) \
            S[kt] = __builtin_amdgcn_mfma_f32_32x32x16_bf16(trd2(kta[kt * 2] + (OFF), kta[kt * 2 + 1] + (OFF)), Vf[SS], S[kt], 0, 0, 0); } while (0)
        HG_UPD(0, 0); HG_UPD(1, 4096); HG_UPD(2, 8192); HG_UPD(3, 12288);
#undef HG_UPD
#pragma unroll
        for (int kt = 0; kt < 4; ++kt)
#pragma unroll
            for (int rr = 0; rr < 4; ++rr) { const f32x4 e4 = *(const LAS f32x4*)(Ld + HG_EE + 4 * (32 * kt + 8 * rr + 4 * h));
#pragma unroll
                for (int j = 0; j < 4; ++j) S[kt][4 * rr + j] *= e4[j]; }
        __syncthreads();
    }
    if (!OUT) {
        GAS float* Lp = (GAS float*)(a.ws + WS_HGL) + ((size_t)(dir * 16 + chain) * 17 + chunk) * HG_LSZ + 32 * wd + qi;
#pragma unroll
        for (int kt = 0; kt < 4; ++kt)
#pragma unroll
            for (int r = 0; r < 16; ++r) Lp[(size_t)(32 * kt + (r & 3) + 8 * (r >> 2) + 4 * h) * 128] = S[kt][r];
        ((float*)(a.ws + WS_HGG))[(((size_t)(dir * 16 + chain) * 17 + chunk) * 2 + half) * 128 + kch] = gtot;
    }
}
__device__ __forceinline__ void p_hg_summaries(const Ctx& F, const Args& a) {
    for (int u = F.vcu; u < 256; u += F.G) hg_unit<false>(F, a, (u >> 4) >> 3, (u >> 4) & 7, u & 15);
}
__device__ __forceinline__ void p_hg_ctx_summaries(const Ctx& F, const Args& a, int first, int nblk) {
    for (int u = F.vcu - first; u >= 0 && u < 16; u += nblk) hg_unit<false>(F, a, u >> 3, u & 7, 16);
}
__device__ __forceinline__ void p_hg_carry(const Ctx& F, const Args& a) {
    const float* Lb = (const float*)(a.ws + WS_HGL); const float* Gb = (const float*)(a.ws + WS_HGG); float* Sb = (float*)(a.ws + WS_HGS);
    for (int i = F.vcu * NTHR + F.tid; i < 32 * 4096; i += F.G * NTHR) {
        const int dc = i >> 12, e4 = (i & 4095) * 4, k = e4 >> 7, dir = dc >> 4;
        const float* Lc = Lb + (size_t)dc * 17 * HG_LSZ + e4; const float* Gc = Gb + (size_t)dc * 17 * 256 + k; float* Sc = Sb + (size_t)dc * 16 * HG_LSZ + e4;
        f32x4 s = *(const GAS f32x4*)(Lc + 16 * HG_LSZ);
#pragma unroll
        for (int j = 0; j < 16; ++j) { const int c = dir ? 15 - j : j;
            *(GAS f32x4*)(Sc + (size_t)c * HG_LSZ) = s;
            s = s * __expf(Gc[c * 256] + Gc[c * 256 + 128]) + *(const GAS f32x4*)(Lc + (size_t)c * HG_LSZ); }
    }
}
__device__ __forceinline__ void hg_norm_unit(const Ctx& F, const Args& a, int b, int hh, int chunk) {
    const bf16* P = (const bf16*)(a.ws + WS_REGA); bf16* CAT = (bf16*)(a.ws + WS_CAT); const float* gain = a.in[11];
    const __amdgpu_buffer_rsrc_t ors = __builtin_amdgcn_make_buffer_rsrc((void*)(a.ws + WS_REGB), 0, 0x7fffffff, 0x00020000);
    int tz = threadIdx.x; asm volatile("" : "+v"(tz));
    const int lane = tz & 63, wv = __builtin_amdgcn_readfirstlane(tz >> 6); const f32x2v gn = *(const GAS f32x2v*)(gain + hh * 128 + 2 * lane);
    for (int r0 = wv * 8; r0 < 256; r0 += NWAVES * 8) {
        float a0[8], a1[8]; unsigned gw[8];
#pragma unroll
        for (int u = 0; u < 8; ++u) { const int t = b * SEQ + chunk * 256 + r0 + u; const unsigned off = (unsigned)(((size_t)t * 1024 + hh * 128 + 2 * lane) * 4);
            const f32x2v f = __builtin_bit_cast(f32x2v, __builtin_amdgcn_raw_buffer_load_b64(ors, (int)off, 0, 0)), bq = __builtin_bit_cast(f32x2v, __builtin_amdgcn_raw_buffer_load_b64(ors, (int)(off + (unsigned)NTOK * 1024u * 4u), 0, 0));
            a0[u] = f[0] + bq[0]; a1[u] = f[1] + bq[1];
            gw[u] = *(const GAS unsigned*)(P + (size_t)t * MIXW + C_HG + hh * 128 + 2 * lane); }
#pragma unroll
        for (int u = 0; u < 8; ++u) { const int t = b * SEQ + chunk * 256 + r0 + u;
            const float r = rsqrtf(wave_sum(a0[u] * a0[u] + a1[u] * a1[u]) * (1.f / 128.f) + NORM_EPS);
            *(GAS unsigned*)(CAT + (size_t)t * D + 1024 + hh * 128 + 2 * lane) = pk2(a0[u] * r * gn[0] * bflo(gw[u]), a1[u] * r * gn[1] * bfhi(gw[u]));   }
    }
}
__device__ __forceinline__ void p_hg_outputs(const Ctx& F, const Args& a) {
    for (int u = F.vcu; u < 256; u += F.G) { const int b = (u >> 4) >> 3, hh = (u >> 4) & 7, chunk = u & 15;
        hg_unit<true>(F, a, b, hh, chunk);
        asm volatile("s_waitcnt vmcnt(0)" ::: "memory"); __syncthreads();
        hg_norm_unit(F, a, b, hh, chunk); }
}
typedef _Float16 f16x8 __attribute__((ext_vector_type(8)));
typedef _Float16 f16x4 __attribute__((ext_vector_type(4)));
__device__ __forceinline__ void route_row(const LAS float* lgv, const float* brg, const float* bre, LAS unsigned* cnt, int* smi, int row) {
    float gl[4]; int gi = 0;
#pragma unroll
    for (int i = 0; i < 4; ++i) gl[i] = lgv[32 + i] + brg[i];
    float gm = gl[0];
#pragma unroll
    for (int i = 1; i < 4; ++i) if (gl[i] > gm) { gm = gl[i]; gi = i; }
    float gz = 0.f;
#pragma unroll
    for (int i = 0; i < 4; ++i) gz += expf(gl[i] - gm);
    const float gval = 1.f / gz;
    float el[8];
#pragma unroll
    for (int j = 0; j < 8; ++j) el[j] = lgv[gi * 8 + j] + bre[gi * 8 + j];
    int i1 = 0; float m1 = el[0];
#pragma unroll
    for (int j = 1; j < 8; ++j) if (el[j] > m1) { m1 = el[j]; i1 = j; }
    int i2 = 0; float m2 = -INFINITY;
#pragma unroll
    for (int j = 0; j < 8; ++j) if (j != i1 && el[j] > m2) { m2 = el[j]; i2 = j; }
    const float p2 = expf(m2 - m1), ga = gval / (1.f + p2), gb = gval * p2 / (1.f + p2);
    const int e1 = gi * 8 + i1, e2 = gi * 8 + i2;
    const int r1 = (int)__hip_atomic_fetch_add(cnt + e1, 1u, __ATOMIC_RELAXED, __HIP_MEMORY_SCOPE_WORKGROUP), r2 = (int)__hip_atomic_fetch_add(cnt + e2, 1u, __ATOMIC_RELAXED, __HIP_MEMORY_SCOPE_WORKGROUP);
    smi[SM_TOKE + 2 * row] = e1; smi[SM_TOKE + 2 * row + 1] = e2; smi[SM_TOKR + 2 * row] = r1; smi[SM_TOKR + 2 * row + 1] = r2;
    ((float*)smi)[SM_TOKG + 2 * row] = ga; ((float*)smi)[SM_TOKG + 2 * row + 1] = gb;
}
template <bool XB>
__device__ __forceinline__ void p_ln_router(const Ctx& F, const Args& a, int layer, const void* xres_, const bf16* Y, bf16* X1, bf16* TOK) {
    const float* xres = (const float*)xres_; const bf16* xrb = (const bf16*)xres_;
    const float* sm = (const float*)(a.ws + WS_SMALL); int* smi = (int*)(a.ws + WS_SMALL);
    const float* lg = a.in[6] + (layer * 2 + 0) * D; const float* lbias = a.in[7] + (layer * 2 + 0) * D;
    const float* brg = a.in[18] + layer * 4; const float* bre = a.in[20] + layer * 32;
    const GAS f16x8* wfr = (const GAS f16x8*)(a.ws + WS_W16) + (size_t)layer * 128 * 2 * 64;
    const int w = F.wave, l = F.lane;
    LAS unsigned char* timg = F.lds;
    LAS float* part = (LAS float*)F.lds;
    LAS float* lgt = (LAS float*)(F.lds + 40960);
    LAS unsigned* lcnt = (LAS unsigned*)(F.lds + 152064);
    if (F.tid < 32) lcnt[F.tid] = 0u;
    for (int grp = F.vcu; grp < NTOK / 32; grp += F.G) {
        __syncthreads();
#pragma unroll 1
        for (int r4 = 0; r4 < 4; ++r4) {
            const int rl = 4 * w + r4, row = grp * 32 + rl, b = row / SEQ; const float* mod = sm + SM_MOD + (layer * 2 + b) * 6 * D;
            f32x4 v[8]; float s = 0.f;
#pragma unroll
            for (int j = 0; j < 8; ++j) { const int d = 4 * l + 256 * j; f32x4 xv; if constexpr (XB) { const v2u xw = *(const GAS v2u*)(xrb + (size_t)row * D + d); xv = (f32x4){bflo(xw.x), bfhi(xw.x), bflo(xw.y), bfhi(xw.y)}; } else xv = *(const GAS f32x4*)(xres + (size_t)row * D + d);
                const f32x4 gv = *(const GAS f32x4*)(mod + 2 * D + d); const v2u yw = *(const GAS v2u*)(Y + (size_t)row * D + d);
                const f32x4 yv = (f32x4){bflo(yw.x), bfhi(yw.x), bflo(yw.y), bfhi(yw.y)};
                v[j] = xv * ALPHA + gv * yv; s += (v[j][0] + v[j][1]) + (v[j][2] + v[j][3]); }
            const float mean = wave_sum(s) * (1.f / D); float q = 0.f;
#pragma unroll
            for (int j = 0; j < 8; ++j) { v[j] = v[j] - mean; q += (v[j][0] * v[j][0] + v[j][1] * v[j][1]) + (v[j][2] * v[j][2] + v[j][3] * v[j][3]); }
            const float rstd = rsqrtf(wave_sum(q) * (1.f / D) + LN_EPS);
#pragma unroll
            for (int j = 0; j < 8; ++j) { const int d = 4 * l + 256 * j; const f32x4 o = v[j] * rstd * *(const GAS f32x4*)(lg + d) + *(const GAS f32x4*)(lbias + d);
                *(GAS v2u*)(X1 + (size_t)row * D + d) = (v2u){pk2(o[0], o[1]), pk2(o[2], o[3])};
                const f32x4 t4 = o * (*(const GAS f32x4*)(mod + 4 * D + d) + 1.f) + *(const GAS f32x4*)(mod + 3 * D + d);
                *(GAS v2u*)(TOK + (size_t)row * D + d) = (v2u){pk2(t4[0], t4[1]), pk2(t4[2], t4[3])};
                *(LAS f16x4*)(timg + rl * 4096 + 16 * ((d >> 3) ^ (rl & 15)) + 2 * (d & 7)) = (f16x4){(_Float16)t4[0], (_Float16)t4[1], (_Float16)t4[2], (_Float16)t4[3]}; }
        }
        __syncthreads();
        f32x16 c0, c1;
#pragma unroll
        for (int r = 0; r < 16; ++r) { c0[r] = 0.f; c1[r] = 0.f; }
        { const int ar = l & 31, ah = l >> 5;
#pragma unroll 4
          for (int ks = 0; ks < 16; ++ks) { const int ksg = 16 * w + ks;
              const f16x8 af = *(const LAS f16x8*)(timg + ar * 4096 + 16 * ((2 * ksg + ah) ^ (ar & 15)));
              const f16x8 b0 = wfr[(size_t)(ksg * 2 + 0) * 64 + l], b1 = wfr[(size_t)(ksg * 2 + 1) * 64 + l];
              c0 = __builtin_amdgcn_mfma_f32_32x32x16_f16(af, b0, c0, 0, 0, 0); c1 = __builtin_amdgcn_mfma_f32_32x32x16_f16(af, b1, c1, 0, 0, 0); } }
        __syncthreads();
        { const int col = l & 31, ah = l >> 5;
#pragma unroll
          for (int r = 0; r < 16; ++r) { const int row = (r & 3) + 8 * (r >> 2) + 4 * ah; part[(w * 32 + row) * 36 + col] = c0[r]; if (col < 4) part[(w * 32 + row) * 36 + 32 + col] = c1[r]; } }
        __syncthreads();
        for (int i = F.tid; i < 32 * 36; i += NTHR) { float sacc = 0.f;
#pragma unroll
            for (int ww = 0; ww < 8; ++ww) sacc += part[ww * 32 * 36 + i];
            lgt[i] = sacc; }
        __syncthreads();
        if (F.tid < 32) route_row(lgt + F.tid * 36, brg, bre, lcnt, smi, grp * 32 + F.tid);
    }
    __syncthreads();
    if (F.tid < 32) smi[SM_BCNT + (layer * 256 + F.vcu) * 32 + F.tid] = (int)lcnt[F.tid];
}
__device__ __forceinline__ void moe_table(const Ctx& F, const Args& a, int layer, bool bases) {
    const int* bc = (const int*)(a.ws + WS_SMALL) + SM_BCNT + layer * 256 * 32;
    LAS int* tab = (LAS int*)(F.lds + LDS_TAB); LAS int* part = (LAS int*)F.lds; LAS int* bb = part + 512;
    const int e = F.tid & 31, seg = F.tid >> 5;
    int sum = 0;
    for (int i = 0; i < 16; ++i) { const int wg = seg * 16 + i; if (wg < F.G) sum += bc[wg * 32 + e]; }
    part[seg * 32 + e] = sum;
    __syncthreads();
    int pre = 0, tot = 0;
    for (int s = 0; s < 16; ++s) { const int v = part[s * 32 + e]; if (s < seg) pre += v; tot += v; }
    if (seg == 0) tab[e] = (tot + 255) >> 8;
    if (bases) { int run = pre; for (int i = 0; i < 16; ++i) { const int wg = seg * 16 + i; if (wg < F.G) { bb[e * 256 + wg] = run; run += bc[wg * 32 + e]; } } }
    __syncthreads();
}
__device__ __forceinline__ void p_gather(const Ctx& F, const Args& a, int layer) {
    moe_table(F, a, layer, true);
    const LAS int* tab = (const LAS int*)(F.lds + LDS_TAB); const LAS int* bb = (const LAS int*)F.lds + 512; int* smi = (int*)(a.ws + WS_SMALL);
    for (int as = F.vcu * NTHR + F.tid; as < 2 * NTOK; as += F.G * NTHR) {
        const int e = smi[SM_TOKE + as], r = smi[SM_TOKR + as], wg = ((as >> 1) >> 5) % F.G; int pre = 0;
        for (int i = 0; i < e; ++i) pre += tab[i];
        const int slot = 256 * pre + bb[e * 256 + wg] + r;
        smi[SM_TOKS + as] = slot; smi[SM_SLOTTOK + slot] = as >> 1;
    }
}
template <bool OB>
__device__ __forceinline__ void p_ln2(const Ctx& F, const Args& a, int layer, void* XO_, bf16* HXN) {
    float* XO = (float*)XO_; bf16* XOB = (bf16*)XO_;
    const float* sm = (const float*)(a.ws + WS_SMALL); const int* smi = (const int*)(a.ws + WS_SMALL);
    const bf16* X1 = (const bf16*)(a.ws + WS_X1); const bf16* YS = (const bf16*)(a.ws + WS_REGB);
    const float* lg = a.in[6] + (layer * 2 + 1) * D; const float* lbias = a.in[7] + (layer * 2 + 1) * D;
    const int l = F.lane;
    for (int row0 = F.vcu * NWAVES + F.wave; row0 < NTOK; row0 += 2 * F.G * NWAVES) {
        f32x4 v[2][8]; float mean[2], rstd[2]; int rows[2]; bool ok[2];
#pragma unroll
        for (int u = 0; u < 2; ++u) { const int row = row0 + u * F.G * NWAVES; ok[u] = row < NTOK; rows[u] = ok[u] ? row : row0;
            const int r = rows[u], b = r / SEQ; const float* mod = sm + SM_MOD + (layer * 2 + b) * 6 * D;
            const int s0 = smi[SM_TOKS + 2 * r], s1 = smi[SM_TOKS + 2 * r + 1]; const float g0 = sm[SM_TOKG + 2 * r], g1 = sm[SM_TOKG + 2 * r + 1];
#pragma unroll
            for (int j = 0; j < 8; ++j) { const int d = 4 * l + 256 * j; const v2u xw = *(const GAS v2u*)(X1 + (size_t)r * D + d); const f32x4 xv = (f32x4){bflo(xw.x), bfhi(xw.x), bflo(xw.y), bfhi(xw.y)}, gv = *(const GAS f32x4*)(mod + 5 * D + d);
                const v2u y0 = *(const GAS v2u*)(YS + (size_t)s0 * D + d), y1 = *(const GAS v2u*)(YS + (size_t)s1 * D + d);
                const f32x4 yv = (f32x4){bflo(y0.x), bfhi(y0.x), bflo(y0.y), bfhi(y0.y)} * g0 + (f32x4){bflo(y1.x), bfhi(y1.x), bflo(y1.y), bfhi(y1.y)} * g1;
                v[u][j] = xv * ALPHA + gv * yv; } }
#pragma unroll
        for (int u = 0; u < 2; ++u) { float s = 0.f;
#pragma unroll
            for (int j = 0; j < 8; ++j) s += (v[u][j][0] + v[u][j][1]) + (v[u][j][2] + v[u][j][3]);
            mean[u] = wave_sum(s) * (1.f / D); float q = 0.f;
#pragma unroll
            for (int j = 0; j < 8; ++j) { v[u][j] = v[u][j] - mean[u]; q += (v[u][j][0] * v[u][j][0] + v[u][j][1] * v[u][j][1]) + (v[u][j][2] * v[u][j][2] + v[u][j][3] * v[u][j][3]); }
            rstd[u] = rsqrtf(wave_sum(q) * (1.f / D) + LN_EPS); }
#pragma unroll
        for (int j = 0; j < 8; ++j) { const int d = 4 * l + 256 * j; const f32x4 lgv = *(const GAS f32x4*)(lg + d), lbv = *(const GAS f32x4*)(lbias + d);
#pragma unroll
            for (int u = 0; u < 2; ++u) { if (!ok[u]) continue; const int row = rows[u], b = row / SEQ; const float* modn = sm + SM_MOD + ((layer + 1) * 2 + b) * 6 * D;
                const f32x4 o = v[u][j] * rstd[u] * lgv + lbv;
                if constexpr (OB) *(GAS v2u*)(XOB + (size_t)row * D + d) = (v2u){pk2(o[0], o[1]), pk2(o[2], o[3])}; else *(GAS f32x4*)(XO + (size_t)row * D + d) = o;
                if (HXN) { const f32x4 hx = o * (*(const GAS f32x4*)(modn + D + d) + 1.f) + *(const GAS f32x4*)(modn + d); *(GAS v2u*)(HXN + (size_t)row * D + d) = (v2u){pk2(hx[0], hx[1]), pk2(hx[2], hx[3])}; } } }
    }
}
template <int W> __device__ __forceinline__ void pool_item8(const bf16* U, bf16* MX, int t0, int d) {
    const int b = t0 / SEQ, n0 = t0 % SEQ, lo0 = n0 - W / 2;
    v4u x[W + 7];
#pragma unroll
    for (int j = 0; j < W + 7; ++j) { const int p = lo0 + j, pc = p < 0 ? 0 : (p >= SEQ ? SEQ - 1 : p); x[j] = *(const GAS v4u*)(U + (size_t)(b * SEQ + pc) * D + d); }
#pragma unroll
    for (int q = 0; q < 8; ++q) {
        float acc[8] = {0.f, 0.f, 0.f, 0.f, 0.f, 0.f, 0.f, 0.f}; int cnt = 0;
#pragma unroll
        for (int j = 0; j < W; ++j) { const int p = lo0 + q + j; const bool ok = (p >= 0) && (p < SEQ); cnt += ok ? 1 : 0; const v4u v = x[q + j];
            if (ok) { acc[0] += bflo(v.x); acc[1] += bfhi(v.x); acc[2] += bflo(v.y); acc[3] += bfhi(v.y); acc[4] += bflo(v.z); acc[5] += bfhi(v.z); acc[6] += bflo(v.w); acc[7] += bfhi(v.w); } }
        const v4u sv = x[q + W / 2]; const float inv = 1.f / (float)cnt;
        *(GAS v4u*)(MX + (size_t)(t0 + q) * D + d) = (v4u){pk2(acc[0] * inv - bflo(sv.x), acc[1] * inv - bfhi(sv.x)), pk2(acc[2] * inv - bflo(sv.y), acc[3] * inv - bfhi(sv.y)),
                                                      pk2(acc[4] * inv - bflo(sv.z), acc[5] * inv - bfhi(sv.z)), pk2(acc[6] * inv - bflo(sv.w), acc[7] * inv - bfhi(sv.w))};
    }
}
__device__ __forceinline__ void p_pool(const Ctx& F, const Args& a) {
    const bf16* U = (const bf16*)(a.ws + WS_REGA); bf16* MX = (bf16*)(a.ws + WS_REGA) + (size_t)NTOK * D;
    for (int i = F.vcu * NTHR + F.tid; i < (NTOK / 8) * (D / 8); i += F.G * NTHR) {
        const int t0 = (i >> 8) * 8, d = (i & 255) * 8, g = d >> 9;
        if (g == 0) pool_item8<2>(U, MX, t0, d); else if (g == 1) pool_item8<4>(U, MX, t0, d); else if (g == 2) pool_item8<8>(U, MX, t0, d); else pool_item8<16>(U, MX, t0, d);
    }
}
#ifndef MK_PER_PHASE
#define MK_PER_PHASE 0
#endif
constexpr int NPHASE = 20;
__global__ void __launch_bounds__(NTHR, 2) fwd(Args args) {
    extern __shared__ __attribute__((aligned(16))) unsigned char lds_raw[];
    Ctx F; F.lds = (LAS unsigned char*)lds_raw; F.tid = threadIdx.x; F.lane = F.tid & 63; F.wave = __builtin_amdgcn_readfirstlane(F.tid >> 6);
    F.G = gridDim.x; { const int bx = blockIdx.x; F.vcu = (F.G % 8 == 0) ? (bx % 8) * (F.G / 8) + bx / 8 : bx; }
    unsigned char* ws = args.ws;
    for (int u = F.tid; u < (LDS_BYTES - LDS_CTLB) / 4; u += NTHR) ((LAS unsigned*)(F.lds + LDS_CTLB))[u] = 0u;
    __syncthreads();
    XcdBarrier bar = xcd_barrier_post((unsigned*)(ws + WS_CTL) + CW_BAR + (MK_PER_PHASE ? args.ph_lo : 0) * XCD_BAR_WORDS, (volatile LAS unsigned*)(F.lds + LDS_MISC) + 8);
    const int lo = args.ph_lo, hi = args.ph_hi;
#define IN(k) (lo <= (k) && (k) < hi)
#define REFRESH_CTX() do { int tz_ = threadIdx.x; asm volatile("" : "+v"(tz_)); F.tid = tz_; F.lane = tz_ & 63; F.wave = __builtin_amdgcn_readfirstlane(tz_ >> 6); } while (0)
#define SEAM(k) do { if (IN(k) && IN((k) + 1)) xcd_barrier(bar); } while (0)
    LAS unsigned char* ring = F.lds;
    const int cid = (int)blockIdx.x;
    bf16* HX = (bf16*)(ws + WS_HX); bf16* P16 = (bf16*)(ws + WS_REGA); bf16* CAT = (bf16*)(ws + WS_CAT); bf16* YXb = (bf16*)(ws + WS_YX);
    bf16* X1 = (bf16*)(ws + WS_X1); bf16* X2 = (bf16*)(ws + WS_X2); bf16* TOK = (bf16*)(ws + WS_TOK);
    bf16* XE = (bf16*)(ws + WS_REGA); bf16* Hb = (bf16*)(ws + WS_H); bf16* YS = (bf16*)(ws + WS_REGB);
    bf16* Ub = (bf16*)(ws + WS_REGA); bf16* MXb = Ub + (size_t)NTOK * D; bf16* YGb = MXb + (size_t)NTOK * D;

    if (IN(0)) { REFRESH_CTX(); p0_mod(F, args, 0, 192, F.vcu, F.G, true); p0_router_frags(F, args); p0_convert(F, args, F.vcu, F.G, false, 192); } SEAM(0);
    if (IN(1)) { REFRESH_CTX(); p1_modulate(F, args); } SEAM(1);
    if (IN(2)) { REFRESH_CTX(); {
        constexpr int NWG = pg8::InprojOrder::NWG; const int nfull = NWG / F.G, nbusy = NWG - nfull * F.G, nfree = F.G - nbusy; const bool tail = nfull > 0 && nbusy > 0 && nfree >= 32;
        unsigned* arrive = (unsigned*)(ws + WS_CTL) + CW_INARR;
        pg8::Gemm g{HX, (const bf16*)(ws + WS_WIN), D, D, D}; pg8::InprojOrder S; S.init(F.G, cid, D, D, tail ? arrive : nullptr);
        pg8::EpiBf16 E{P16, MIXW, nullptr, MIXW / 256, C_HQ / 256, C_FF / 256, C_HG / 256, MIXW / 256, C_V / 256, NTOK};
        pg8::gemm_phase<pg8::EpiBf16, pg8::InprojOrder, true, true>(ring, g, S, E);
        if (tail) { const int me = cid - nbusy;
            if (me >= 0 && me < 16) {
                if (threadIdx.x == 0) { unsigned* bw = bar.bar; XB_SPIN(xb_ld(arrive) < (unsigned)pg8::InprojOrder::NCTXU, bw); __builtin_amdgcn_fence(__ATOMIC_ACQUIRE, "agent"); asm volatile("s_waitcnt vmcnt(0)" ::: "memory"); }
                __syncthreads();
                hg_unit<false>(F, args, me >> 3, me & 7, 16);
                __syncthreads();
            }
            p0_mod(F, args, 192, 384, me, nfree, false, (unsigned*)(ws + WS_CTL) + CW_GVQ);
            __syncthreads(); p0_convert(F, args, me, nfree, false, -1);
        } else { p0_mod(F, args, 192, 384, nbusy > 0 ? cid - nbusy : F.vcu, nbusy > 0 ? nfree : F.G, false); __syncthreads(); p0_convert(F, args, F.vcu, F.G, false, -1); xcd_barrier(bar); p_hg_ctx_summaries(F, args, 0, F.G); } } }
    do { if (IN(2) && IN(4)) xcd_barrier(bar); } while (0);
    if (IN(4)) { REFRESH_CTX();
        p4_attn_mfma(F, args); p_hg_summaries(F, args);
    } SEAM(4);
    if (IN(5)) { REFRESH_CTX();
        p_hg_carry(F, args);
    } SEAM(5);
    if (IN(6)) { REFRESH_CTX();
        p_hg_outputs(F, args);
    } SEAM(6);
    if (IN(7)) { REFRESH_CTX(); { pg8::Gemm g{CAT, (const bf16*)(ws + WS_WOUT), D, D, D}; pg8::StaticOrder S; S.init(NTOK, D, F.G, cid, D, D); pg8::EpiBf16 E{YXb, D, nullptr, 8}; pg8::gemm_phase<pg8::EpiBf16, pg8::StaticOrder, true, true>(ring, g, S, E); } } SEAM(7);
    if (IN(8)) { REFRESH_CTX(); p_ln_router<false>(F, args, 0, args.in[0], YXb, X1, TOK); } SEAM(8);
    if (IN(9)) { REFRESH_CTX(); const bool has_slots = F.vcu * NTHR < 2 * NTOK;
        if (has_slots) p_gather(F, args, 0);
        {
          __syncthreads(); const bool sw = (F.G % 8 == 0) && F.G >= 16; const int xi = cid & 7, fold = sw ? (xi ? (cid >> 3) * 7 + xi - 1 : -1) : cid, fstride = sw ? (F.G / 8) * 7 : F.G;
          pg8::Gemm g{(const bf16*)(ws + WS_WPOUT), (const bf16*)(ws + WS_WGRP), 512, D, 512}; pg8::FoldOrder S{fold, fstride, D, 512}; pg8::EpiBf16 E{(bf16*)(ws + WS_WFOLD), D, nullptr, 8};
          pg8::gemm_phase<pg8::EpiBf16, pg8::FoldOrder, true, true>(ring, g, S, E);
          if (sw && fstride >= 128) p0_convert(F, args, fold - 64, fstride - 64, true); else p0_convert(F, args, F.vcu, F.G, true); }
        if (!has_slots) { __syncthreads(); moe_table(F, args, 0, false); } } SEAM(9);
    if (IN(10)) { REFRESH_CTX(); { if (MK_PER_PHASE) moe_table(F, args, 0, false);     pg8::FusedOrder S; S.init((const LAS int*)(F.lds + LDS_TAB), F.G, F.vcu); pg8::MoeCfg c0{TOK, D, (const int*)(ws + WS_SMALL) + SM_SLOTTOK, D, args.in[21] + (size_t)0 * NEXP * D * FF, args.in[22] + (size_t)0 * NEXP * D * FF, FF, (size_t)D * FF, 128, 4}; pg8::MoeCfg c1{Hb, FF, nullptr, FF, args.in[23] + (size_t)0 * NEXP * FF * D, args.in[23] + (size_t)0 * NEXP * FF * D + 128, D, (size_t)FF * D, 256, 8}; pg8::EpiSwiglu EA{Hb}; pg8::EpiBf16 EB{YS, D, nullptr, 8}; pg8::gemm_moe_fused<pg8::EpiSwiglu, pg8::EpiBf16>(ring, c0, c1, (unsigned*)(ws + WS_CTL) + CW_MCNT + 0 * 128, ws + WS_XBUF, (unsigned*)(ws + WS_CTL) + CW_XCNT + 0 * 512, S, EA, EB); } } SEAM(10);
    if (IN(11)) { REFRESH_CTX(); p_ln2<true>(F, args, 0, X2, HX); } SEAM(11);
    if (IN(12)) { REFRESH_CTX(); { pg8::Gemm g{HX, (const bf16*)(ws + WS_WPIN), D, D, D}; pg8::StaticOrder S; S.init(NTOK, D, F.G, cid, D, D);
        if (F.G == (NTOK / 256) * (D / 256)) {
            pg8::EpiPool E{MXb, ws + WS_HALO, (unsigned*)(ws + WS_CTL) + CW_HCNT, D, SEQ / 256}; pg8::gemm_phase<pg8::EpiPool, pg8::StaticOrder, true, true>(ring, g, S, E);
        } else { pg8::EpiBf16 E{Ub, D, nullptr, 8}; pg8::gemm_phase<pg8::EpiBf16, pg8::StaticOrder, true, true>(ring, g, S, E); } } }
    if (IN(12) && IN(13) && F.G != (NTOK / 256) * (D / 256)) xcd_barrier(bar);
    if (IN(13)) { REFRESH_CTX(); if (F.G != (NTOK / 256) * (D / 256)) p_pool(F, args); } do { if (IN(13) && IN(15)) xcd_barrier(bar); } while (0);
    if (IN(15)) { REFRESH_CTX(); { pg8::Gemm g{MXb, (const bf16*)(ws + WS_WFOLD), D, D, D}; pg8::StaticOrder S; S.init(NTOK, D, F.G, cid, D, D); pg8::EpiBf16 E{YXb, D, nullptr, 8}; pg8::gemm_phase<pg8::EpiBf16, pg8::StaticOrder, true, true>(ring, g, S, E); } } SEAM(15);
    if (IN(16)) { REFRESH_CTX(); p_ln_router<true>(F, args, 1, X2, YXb, X1, TOK); } SEAM(16);
    if (IN(17)) { REFRESH_CTX(); p_gather(F, args, 1); } SEAM(17);
    if (IN(18)) { REFRESH_CTX(); { if (MK_PER_PHASE) moe_table(F, args, 1, false);     pg8::FusedOrder S; S.init((const LAS int*)(F.lds + LDS_TAB), F.G, F.vcu); pg8::MoeCfg c0{TOK, D, (const int*)(ws + WS_SMALL) + SM_SLOTTOK, D, args.in[21] + (size_t)1 * NEXP * D * FF, args.in[22] + (size_t)1 * NEXP * D * FF, FF, (size_t)D * FF, 128, 4}; pg8::MoeCfg c1{Hb, FF, nullptr, FF, args.in[23] + (size_t)1 * NEXP * FF * D, args.in[23] + (size_t)1 * NEXP * FF * D + 128, D, (size_t)FF * D, 256, 8}; pg8::EpiSwiglu EA{Hb}; pg8::EpiBf16 EB{YS, D, nullptr, 8}; pg8::gemm_moe_fused<pg8::EpiSwiglu, pg8::EpiBf16>(ring, c0, c1, (unsigned*)(ws + WS_CTL) + CW_MCNT + 1 * 128, ws + WS_XBUF, (unsigned*)(ws + WS_CTL) + CW_XCNT + 1 * 512, S, EA, EB); } } SEAM(18);
    if (IN(19)) { REFRESH_CTX(); p_ln2<false>(F, args, 1, args.out, nullptr); }
#undef IN
#undef SEAM
}

extern "C" void kernel_launch(void* const* d_in, const int* in_sizes, int n_in, void* d_out, int out_size, void* d_ws, size_t ws_size, hipStream_t stream) {
    static int grid = 0;
    if (grid == 0) {
        if (n_in != 24 || ws_size < WS_END) { fprintf(stderr, "kernel_launch: need 24 inputs and >= %zu bytes of workspace (got %d, %zu)\n", (size_t)WS_END, n_in, ws_size); grid = -1; return; }
        int dev = 0, cus = 0;
        if (hipGetDevice(&dev) != hipSuccess || hipDeviceGetAttribute(&cus, hipDeviceAttributeMultiprocessorCount, dev) != hipSuccess) { grid = -1; return; }
        if (hipFuncSetAttribute((const void*)fwd, hipFuncAttributeMaxDynamicSharedMemorySize, LDS_BYTES) != hipSuccess) { fprintf(stderr, "kernel_launch: hipFuncSetAttribute failed\n"); grid = -1; return; }
        int per_cu = 0;
        if (hipOccupancyMaxActiveBlocksPerMultiprocessor(&per_cu, (const void*)fwd, NTHR, LDS_BYTES) != hipSuccess || per_cu < 1) { fprintf(stderr, "kernel_launch: occupancy query says %d blocks per CU\n", per_cu); }
        (void)hipGetLastError();
        grid = cus;
    }
    if (grid < 0) return;
    if (hipMemsetAsync((char*)d_ws + WS_CTL, 0, CTL_ZERO_BYTES, stream) != hipSuccess) return;
    Args a{};
    for (int i = 0; i < 24; ++i) a.in[i] = (const float*)d_in[i];
    a.out = (float*)d_out; a.ws = (unsigned char*)d_ws;
#if MK_PER_PHASE
    for (int p = 0; p < NPHASE; ++p) { a.ph_lo = p; a.ph_hi = p + 1; hipLaunchKernelGGL(fwd, dim3(grid), dim3(NTHR), LDS_BYTES, stream, a); }
#else
    a.ph_lo = 0; a.ph_hi = NPHASE;
    hipLaunchKernelGGL(fwd, dim3(grid), dim3(NTHR), LDS_BYTES, stream, a);
#endif
    const hipError_t le = hipPeekAtLastError();
    if (le != hipSuccess) fprintf(stderr, "kernel_launch: launch failed: %s\n", hipGetErrorName(le));
}
```

```cpp
#include <hip/hip_runtime.h>
#include <cstdio>
#include <cstdint>

namespace pg8 {
#define PG8_LAS __attribute__((address_space(3)))
typedef unsigned short bf16_t;
typedef short bf16x8 __attribute__((ext_vector_type(8)));
typedef float f32x4 __attribute__((ext_vector_type(4)));
typedef unsigned u32x4 __attribute__((ext_vector_type(4)));
constexpr int BM = 256, BK = 64, HALF = 128, HTB = HALF * BK * 2  , STAGE_BYTES = 8 * HTB, NXCD = 8, WGM = 8;

__host__ __device__ __forceinline__ int lds_byte(int r, int c) { const int st = (r >> 4) * 2 + (c >> 5), rr = r & 15, cc = c & 31, ob = rr * 64 + cc * 2; return st * 1024 + (ob ^ (((ob >> 9) & 1) << 5)); }
__host__ __device__ __forceinline__ void stage_rc(int b, int& R, int& C) { const int st = b / 1024, sb = b % 1024, swz = sb ^ (((sb >> 9) & 1) << 5); R = (st >> 1) * 16 + swz / 64; C = (st & 1) * 32 + (swz % 64) / 2; }
__host__ __device__ __forceinline__ int perm32(int rho) { const int n = rho >> 4, i = rho & 15; return 8 * (i >> 2) + 4 * n + (i & 3); }

struct Unit { int pm, pn; };
struct Gemm { const bf16_t* A; const bf16_t* Bt; int K, lda, ldb; };
__device__ __forceinline__ unsigned cvt_pk_bf16(float lo, float hi) { unsigned r; asm volatile("v_cvt_pk_bf16_f32 %0, %1, %2" : "=v"(r) : "v"(lo), "v"(hi)); return r; }
template <class Epi, class Sched, bool ALIGN_EPI = false, bool SP2 = false>
__device__ __forceinline__ void gemm_phase(PG8_LAS unsigned char* lds, const Gemm g, const Sched& S, const Epi& E) {
    const int tid = threadIdx.x, wid = __builtin_amdgcn_readfirstlane(tid >> 6), lane = tid & 63, wr = wid >> 2, wc = wid & 3, fr = lane & 15, fq = lane >> 4;
    const int K = g.K, nt = K / BK;
    unsigned voffA[2], voffB[2];
#pragma unroll
    for (int i = 0; i < 2; ++i) { int R, C; stage_rc(tid * 16 + i * 8192, R, C); const int Rb = Epi::PERM ? ((R & ~31) + perm32(R & 31)) : R;
        voffA[i] = (unsigned)(R * g.lda + C) * 2u; voffB[i] = (unsigned)(Rb * g.ldb + C) * 2u; }
    const size_t kstep = (size_t)(BK * 2);
    const size_t hsA = (size_t)HALF * g.lda * 2, hsB = (size_t)HALF * g.ldb * 2;
    const unsigned ldsw = (unsigned)wid * 1024u;
    const int aoff = lds_byte(wr * 64 + fr, fq * 8), boff = lds_byte(wc * 32 + fr, fq * 8);
#define PG8_SA(b, h) (((b) * 2 + (h)) * HTB)
#define PG8_SB(b, h) ((4 + (b) * 2 + (h)) * HTB)
#define PG8_STAGE(bufoff, gbase, voff) do { _Pragma("unroll") for (int _i = 0; _i < 2; ++_i) \
        __builtin_amdgcn_global_load_lds((const unsigned*)((const char*)(gbase) + (voff)[_i]), (PG8_LAS unsigned*)(lds + (bufoff) + ldsw + _i * 8192), 16, 0, 0); } while (0)
#define PG8_LDA(dst, b, h) do { _Pragma("unroll") for (int m = 0; m < 4; ++m) _Pragma("unroll") for (int k = 0; k < 2; ++k) dst[m][k] = *(const PG8_LAS bf16x8*)(lds + PG8_SA(b, h) + aoff + m * 2048 + k * 1024); } while (0)
#define PG8_LDB(dst, b, h) do { _Pragma("unroll") for (int n = 0; n < 2; ++n) _Pragma("unroll") for (int k = 0; k < 2; ++k) dst[n][k] = *(const PG8_LAS bf16x8*)(lds + PG8_SB(b, h) + boff + n * 2048 + k * 1024); } while (0)
#define PG8_MMA(ai, bj, At, Bt) do { __builtin_amdgcn_s_setprio(1); _Pragma("unroll") for (int m = 0; m < 4; ++m) _Pragma("unroll") for (int n = 0; n < 2; ++n) _Pragma("unroll") for (int k = 0; k < 2; ++k) \
        acc[ai][bj][m][n] = __builtin_amdgcn_mfma_f32_16x16x32_bf16(Bt[n][k], At[m][k], acc[ai][bj][m][n], 0, 0, 0); __builtin_amdgcn_s_setprio(0); } while (0)
#define PG8_WAIT_V(n) asm volatile("s_waitcnt vmcnt(" #n ")" ::: "memory")
#define PG8_WAIT_L(n) asm volatile("s_waitcnt lgkmcnt(" #n ")" ::: "memory")
#define PG8_BAR __builtin_amdgcn_s_barrier()
#define PG8_SCHED __builtin_amdgcn_sched_barrier(0)
    Unit cur, nxt; int ui = 0;
    if (!S.next(0, cur)) return;
    f32x4 acc[2][2][4][2];
#pragma unroll
    for (int a = 0; a < 2; ++a)
#pragma unroll
        for (int b = 0; b < 2; ++b)
#pragma unroll
            for (int m = 0; m < 4; ++m)
#pragma unroll
                for (int n = 0; n < 2; ++n) acc[a][b][m][n] = (f32x4){0.f, 0.f, 0.f, 0.f};
    bf16x8 At[4][2], B0[2][2], B1[2][2];
    const char* cA = (const char*)g.A + S.aoff(cur); const char* cB = (const char*)g.Bt + S.boff(cur);
    S.a_ready(cur);
    if constexpr (SP2) {
        PG8_STAGE(PG8_SB(0, 0), cB, voffB); PG8_STAGE(PG8_SB(0, 1), cB + hsB, voffB); PG8_STAGE(PG8_SA(0, 0), cA, voffA); PG8_STAGE(PG8_SA(0, 1), cA + hsA, voffA);
        if (wr == 1) PG8_BAR;
        PG8_WAIT_V(2); PG8_BAR;
        PG8_STAGE(PG8_SB(1, 0), cB + kstep, voffB); PG8_STAGE(PG8_SA(1, 0), cA + kstep, voffA); PG8_STAGE(PG8_SB(1, 1), cB + hsB + kstep, voffB);
        PG8_WAIT_V(6); PG8_BAR;
    } else {
        PG8_STAGE(PG8_SB(0, 0), cB, voffB); PG8_STAGE(PG8_SA(0, 0), cA, voffA); PG8_STAGE(PG8_SB(0, 1), cB + hsB, voffB); PG8_STAGE(PG8_SA(0, 1), cA + hsA, voffA);
        if (wr == 1) PG8_BAR;
        PG8_WAIT_V(4); PG8_BAR;
        PG8_STAGE(PG8_SB(1, 0), cB + kstep, voffB); PG8_STAGE(PG8_SA(1, 0), cA + kstep, voffA); PG8_STAGE(PG8_SB(1, 1), cB + hsB + kstep, voffB);
        PG8_WAIT_V(6); PG8_BAR;
    }
    for (;;) {
        const bool has_next = S.next(ui + 1, nxt);
        const char* nA = has_next ? (const char*)g.A + S.aoff(nxt) : cA; const char* nB = has_next ? (const char*)g.Bt + S.boff(nxt) : cB;
        for (int t = 0; t < nt; t += 2) {
            const bool last = (t == nt - 2);
            const char* a1 = cA + (size_t)(t + 1) * kstep;
            const char* a2 = last ? nA : cA + (size_t)(t + 2) * kstep; const char* b2 = last ? nB : cB + (size_t)(t + 2) * kstep;
            const char* a3 = a2 + kstep; const char* b3 = b2 + kstep;
            if (last && has_next) S.a_ready(nxt);
            if constexpr (SP2) {
            PG8_LDB(B0, 0, 0); PG8_LDB(B1, 0, 1); PG8_SCHED; PG8_LDA(At, 0, 0); PG8_STAGE(PG8_SA(1, 1), a1 + hsA, voffA);
            PG8_WAIT_V(8); PG8_WAIT_L(0); PG8_BAR; PG8_MMA(0, 0, At, B0); PG8_MMA(0, 1, At, B1); PG8_BAR; PG8_SCHED;
            PG8_LDA(At, 0, 1); PG8_STAGE(PG8_SB(0, 0), b2, voffB); PG8_STAGE(PG8_SB(0, 1), b2 + hsB, voffB); PG8_STAGE(PG8_SA(0, 0), a2, voffA);
            PG8_WAIT_V(8); PG8_WAIT_L(0); PG8_BAR; PG8_MMA(1, 0, At, B0); PG8_MMA(1, 1, At, B1); PG8_BAR; PG8_SCHED;
            PG8_LDB(B0, 1, 0); PG8_LDB(B1, 1, 1); PG8_SCHED; PG8_LDA(At, 1, 0); PG8_STAGE(PG8_SA(0, 1), a2 + hsA, voffA);
            PG8_WAIT_V(8); PG8_WAIT_L(0); PG8_BAR; PG8_MMA(0, 0, At, B0); PG8_MMA(0, 1, At, B1); PG8_BAR; PG8_SCHED;
            PG8_LDA(At, 1, 1); PG8_STAGE(PG8_SB(1, 0), b3, voffB); PG8_STAGE(PG8_SB(1, 1), b3 + hsB, voffB); PG8_STAGE(PG8_SA(1, 0), a3, voffA);
            PG8_WAIT_V(8); PG8_WAIT_L(0); PG8_BAR; PG8_MMA(1, 0, At, B0); PG8_MMA(1, 1, At, B1); PG8_BAR; PG8_SCHED;
            } else {
            PG8_LDB(B0, 0, 0); PG8_SCHED; PG8_LDA(At, 0, 0); PG8_STAGE(PG8_SA(1, 1), a1 + hsA, voffA);
            PG8_WAIT_L(8); PG8_BAR; PG8_WAIT_L(0); PG8_MMA(0, 0, At, B0); PG8_BAR; PG8_SCHED;
            PG8_LDB(B1, 0, 1); PG8_STAGE(PG8_SB(0, 0), b2, voffB);
            PG8_BAR; PG8_WAIT_L(0); PG8_MMA(0, 1, At, B1); PG8_BAR;
            PG8_LDA(At, 0, 1); PG8_STAGE(PG8_SA(0, 0), a2, voffA);
            PG8_BAR; PG8_WAIT_L(0); PG8_MMA(1, 0, At, B0); PG8_BAR; PG8_SCHED;
            PG8_STAGE(PG8_SB(0, 1), b2 + hsB, voffB);
            PG8_WAIT_V(6); PG8_BAR; PG8_MMA(1, 1, At, B1); PG8_BAR;
            PG8_LDB(B0, 1, 0); PG8_SCHED; PG8_LDA(At, 1, 0); PG8_STAGE(PG8_SA(0, 1), a2 + hsA, voffA);
            PG8_WAIT_L(8); PG8_BAR; PG8_WAIT_L(0); PG8_MMA(0, 0, At, B0); PG8_BAR; PG8_SCHED;
            PG8_LDB(B1, 1, 1); PG8_STAGE(PG8_SB(1, 0), b3, voffB);
            PG8_BAR; PG8_WAIT_L(0); PG8_MMA(0, 1, At, B1); PG8_BAR;
            PG8_LDA(At, 1, 1); PG8_STAGE(PG8_SA(1, 0), a3, voffA);
            PG8_BAR; PG8_WAIT_L(0); PG8_MMA(1, 0, At, B0); PG8_BAR; PG8_SCHED;
            PG8_STAGE(PG8_SB(1, 1), b3 + hsB, voffB);
            PG8_WAIT_V(6); PG8_BAR; PG8_MMA(1, 1, At, B1); PG8_BAR;
            }
        }
        if constexpr (ALIGN_EPI) { if (wr == 0) PG8_BAR; }
        if constexpr (!Epi::AFTER_DRAIN) { E(acc, cur, wr, wc, fr, fq); S.done(cur); }
        if (!has_next) break;
#pragma unroll
        for (int a = 0; a < 2; ++a)
#pragma unroll
            for (int b = 0; b < 2; ++b)
#pragma unroll
                for (int m = 0; m < 4; ++m)
#pragma unroll
                    for (int n = 0; n < 2; ++n) acc[a][b][m][n] = (f32x4){0.f, 0.f, 0.f, 0.f};
        cur = nxt; cA = nA; cB = nB; ++ui;
        if constexpr (ALIGN_EPI) { if (wr == 1) PG8_BAR; }
    }
    PG8_WAIT_V(0);
    if constexpr (!ALIGN_EPI) { if (wr == 0) PG8_BAR; }
    PG8_BAR;
    if constexpr (Epi::AFTER_DRAIN) { E.fused(acc, cur, wr, wc, fr, fq, lds, wid, lane); S.done(cur); }
#undef PG8_SA
#undef PG8_SB
#undef PG8_STAGE
#undef PG8_LDA
#undef PG8_LDB
#undef PG8_MMA
#undef PG8_WAIT_V
#undef PG8_WAIT_L
#undef PG8_BAR
#undef PG8_SCHED
}
}
namespace pg8 {
struct StaticOrder {
    int nM, nN, nwg, G, c, lda, ldb;
    __host__ __device__ void init(int M, int N, int G_, int c_, int lda_, int ldb_) { nM = M / BM; nN = N / BM; nwg = nM * nN; G = G_; c = c_; lda = lda_; ldb = ldb_; }
    __host__ __device__ bool next(int i, Unit& u) const {
        const long L = (long)i * G + c; if (L >= nwg) return false;
        int wgid = (int)L; { const int q = nwg / NXCD, r = nwg % NXCD, xcd = wgid % NXCD, off = wgid / NXCD; wgid = (xcd < r ? xcd * (q + 1) : r * (q + 1) + (xcd - r) * q) + off; }
        const int nig = WGM * nN, gid = wgid / nig, fm = gid * WGM, gsz = (nM - fm) < WGM ? (nM - fm) : WGM;
        u.pm = fm + ((wgid % nig) % gsz); u.pn = (wgid % nig) / gsz; return true;
    }
    __device__ __forceinline__ size_t aoff(const Unit& u) const { return (size_t)u.pm * BM * lda * 2; }
    __device__ __forceinline__ size_t boff(const Unit& u) const { return (size_t)u.pn * BM * ldb * 2; }
    __device__ __forceinline__ void a_ready(const Unit&) const {}
    __device__ __forceinline__ void done(const Unit&) const {}
};
struct InprojOrder {
    static constexpr int NCTXU = 32, NLAT = 32 * 28, NWG = NCTXU + NLAT;
    int G, c, lda, ldb; unsigned* cnt;
    __device__ __forceinline__ void init(int G_, int c_, int lda_, int ldb_, unsigned* cnt_) { G = G_; c = c_; lda = lda_; ldb = ldb_; cnt = cnt_; }
    __device__ __forceinline__ bool next(int i, Unit& u) const {
        const long L = (long)i * G + c; if (L >= NWG) return false;
        if (L < NCTXU) { const int t = (int)L & 15; u.pm = 32 + ((int)L >> 4); u.pn = t < 4 ? 4 + t : 8 + t; return true; }
        int wgid = (int)L - NCTXU; { const int q = NLAT / NXCD, xcd = wgid % NXCD, off = wgid / NXCD; wgid = xcd * q + off; }
        const int nig = WGM * 28, gid = wgid / nig, fm = gid * WGM;
        u.pm = fm + ((wgid % nig) % WGM); u.pn = (wgid % nig) / WGM; return true;
    }
    __device__ __forceinline__ size_t aoff(const Unit& u) const { return (size_t)u.pm * BM * lda * 2; }
    __device__ __forceinline__ size_t boff(const Unit& u) const { return (size_t)u.pn * BM * ldb * 2; }
    __device__ __forceinline__ void a_ready(const Unit&) const {}
    __device__ __forceinline__ void done(const Unit& u) const {
        if (!cnt || u.pm < 32) return;
        asm volatile("s_waitcnt vmcnt(0)" ::: "memory"); __syncthreads();
        if (threadIdx.x == 0) { __builtin_amdgcn_fence(__ATOMIC_RELEASE, "agent"); asm volatile("s_waitcnt vmcnt(0)" ::: "memory");
            (void)__hip_atomic_fetch_add(cnt, 1u, __ATOMIC_RELAXED, __HIP_MEMORY_SCOPE_AGENT); }
    }
};
struct FoldOrder {
    int idx, stride, lda, ldb;
    __device__ __forceinline__ bool next(int i, Unit& u) const { const int L = idx + i * stride; if (idx < 0 || L >= 64) return false; u.pm = L >> 3; u.pn = L & 7; return true; }
    __device__ __forceinline__ size_t aoff(const Unit& u) const { return (size_t)u.pm * BM * lda * 2 + (size_t)(u.pn >> 1) * 512 * 2; }
    __device__ __forceinline__ size_t boff(const Unit& u) const { return (size_t)u.pn * BM * ldb * 2; }
    __device__ __forceinline__ void a_ready(const Unit&) const {}
    __device__ __forceinline__ void done(const Unit&) const {}
};
struct EpiF32 {
    static constexpr bool PERM = false, AFTER_DRAIN = false;
    float* C; int ldc;
    __device__ __forceinline__ void operator()(const f32x4 (&acc)[2][2][4][2], const Unit& u, int wr, int wc, int fr, int fq) const {
        const int row0 = u.pm * BM + wr * 64 + fr, col0 = u.pn * BM + wc * 32 + 4 * fq;
#pragma unroll
        for (int ai = 0; ai < 2; ++ai)
#pragma unroll
            for (int m = 0; m < 4; ++m) { float* rowp = C + (size_t)(row0 + ai * HALF + m * 16) * ldc + col0;
#pragma unroll
                for (int bj = 0; bj < 2; ++bj)
#pragma unroll
                    for (int n = 0; n < 2; ++n) *(f32x4*)(rowp + bj * HALF + n * 16) = acc[ai][bj][m][n]; }
    }
};
struct EpiBf16 {
    static constexpr bool PERM = true, AFTER_DRAIN = false;
    bf16_t* O; int ldc; const float* scale; int ncolt; int silu_lo = 0, silu_hi = 0, silu_lo2 = 0, silu_hi2 = 0;
    int rope_tiles = 0, rope_rows = 0;
    __device__ __forceinline__ void operator()(const f32x4 (&acc)[2][2][4][2], const Unit& u, int wr, int wc, int fr, int fq) const {
        const int row0 = u.pm * BM + wr * 64 + fr, col0 = (u.pn % ncolt) * BM + wc * 32 + 8 * fq;
        const int ct = u.pn % ncolt; const bool act = (ct >= silu_lo && ct < silu_hi) || (ct >= silu_lo2 && ct < silu_hi2);
        const bool rp = ct < rope_tiles && u.pm * BM < rope_rows;
        float invf[4] = {0.f, 0.f, 0.f, 0.f};
        if (rp) {
#pragma unroll
            for (int j = 0; j < 4; ++j) invf[j] = __builtin_amdgcn_exp2f(-(float)(16 * (wc & 1) + 4 * fq + j) * (13.287712379549449f / 32.0f)) * 0.15915494309189535f; }
        f32x4 sv[2][2];
#pragma unroll
        for (int bj = 0; bj < 2; ++bj)
#pragma unroll
            for (int n = 0; n < 2; ++n) sv[bj][n] = scale ? *(const f32x4*)(scale + col0 + bj * HALF + 4 * n) : (f32x4){1.f, 1.f, 1.f, 1.f};
#pragma unroll
        for (int ai = 0; ai < 2; ++ai)
#pragma unroll
            for (int m = 0; m < 4; ++m) { bf16_t* rowp = O + (size_t)(row0 + ai * HALF + m * 16) * ldc + col0;
                float pos = 0.f;
                if (rp) { const int nseq = (row0 + ai * HALF + m * 16) & 4095; pos = (wc >> 1) ? (float)(nseq & 63) : (float)(nseq >> 6); }
#pragma unroll
                for (int bj = 0; bj < 2; ++bj) { f32x4 v0 = acc[ai][bj][m][0] * sv[bj][0], v1 = acc[ai][bj][m][1] * sv[bj][1];
                    if (rp) {
#pragma unroll
                        for (int j = 0; j < 4; ++j) { const float rev = pos * invf[j], rc = __builtin_amdgcn_cosf(rev), rs = __builtin_amdgcn_sinf(rev), xa = v0[j], xb = v1[j]; v0[j] = xa * rc - xb * rs; v1[j] = xb * rc + xa * rs; } }
                    if (act) {
#pragma unroll
                        for (int i = 0; i < 4; ++i) { v0[i] = v0[i] * __builtin_amdgcn_rcpf(1.f + __builtin_amdgcn_exp2f(-1.4426950408889634f * v0[i])); v1[i] = v1[i] * __builtin_amdgcn_rcpf(1.f + __builtin_amdgcn_exp2f(-1.4426950408889634f * v1[i])); } }
                    u32x4 w; w.x = cvt_pk_bf16(v0[0], v0[1]); w.y = cvt_pk_bf16(v0[2], v0[3]); w.z = cvt_pk_bf16(v1[0], v1[1]); w.w = cvt_pk_bf16(v1[2], v1[3]);
                    *(u32x4*)(rowp + bj * HALF) = w; } }
    }
};
template <unsigned N> struct PoolC { static constexpr unsigned value = N; };
struct EpiPool {
    static constexpr bool PERM = true, AFTER_DRAIN = true;
    bf16_t* MX; unsigned char* halo; unsigned* hcnt; int ldc; int tiles_per_seq;
    __device__ __forceinline__ void fused(f32x4 (&acc)[2][2][4][2], const Unit& u, int wr, int wc, int fr, int fq, PG8_LAS unsigned char* lds, int wid, int lane) const {
        const int tid = wid * 64 + lane;
        PG8_LAS unsigned char* T = lds; PG8_LAS unsigned char* HL = lds + 131072;
        const __amdgpu_buffer_rsrc_t hrs = __builtin_amdgcn_make_buffer_rsrc((void*)halo, 0, 0x7fffffff, 0x00020000);
        const unsigned hme = (unsigned)(u.pm * 8 + u.pn) * 8192u;
#pragma unroll
        for (int ai = 0; ai < 2; ++ai)
#pragma unroll
            for (int m = 0; m < 4; ++m) { const int row = ai * HALF + wr * 64 + m * 16 + fr;
#pragma unroll
                for (int bj = 0; bj < 2; ++bj) { const int ch = bj * 16 + wc * 4 + fq; const f32x4 v0 = acc[ai][bj][m][0], v1 = acc[ai][bj][m][1];
                    u32x4 w; w.x = cvt_pk_bf16(v0[0], v0[1]); w.y = cvt_pk_bf16(v0[2], v0[3]); w.z = cvt_pk_bf16(v1[0], v1[1]); w.w = cvt_pk_bf16(v1[2], v1[3]);
                    *(PG8_LAS u32x4*)(T + row * 512 + 16 * (ch ^ (row & 15))) = w;
                    if (row < 8 || row >= 248) __builtin_amdgcn_raw_buffer_store_b128(w, hrs, (int)(hme + (unsigned)((row < 8 ? row : row - 240) * 512 + ch * 16)), 0, 16); } }
        asm volatile("s_waitcnt vmcnt(0)" ::: "memory"); __syncthreads();
        if (tid == 0) __hip_atomic_fetch_add(hcnt + u.pm * 8 + u.pn, 1u, __ATOMIC_RELAXED, __HIP_MEMORY_SCOPE_AGENT);
        const int nloc = u.pm % tiles_per_seq; const bool hasup = nloc != 0, hasdn = nloc != tiles_per_seq - 1;
        const int W = 2 << (u.pn >> 1), hW = W >> 1, n0 = nloc * BM, nseq = tiles_per_seq * BM;
        auto strip_pool = [&](const int strip, const int ch, auto edge) __attribute__((always_inline)) {
            constexpr bool EDGE = decltype(edge)::value != 0u;
            const int r0 = strip * 16;
            float sum[8] = {0.f, 0.f, 0.f, 0.f, 0.f, 0.f, 0.f, 0.f};
            auto rd = [&](int q) -> u32x4 { if (EDGE) { if (q < 0) return *(const PG8_LAS u32x4*)(HL + (8 + q) * 512 + ch * 16); if (q >= BM) return *(const PG8_LAS u32x4*)(HL + (8 + q - BM) * 512 + ch * 16); }
                return *(const PG8_LAS u32x4*)(T + q * 512 + 16 * (ch ^ (q & 15))); };
            auto acc8 = [&](const u32x4 w, auto neg) { constexpr bool NEG = decltype(neg)::value != 0u;
                const float f0 = __builtin_bit_cast(float, w.x << 16), f1 = __builtin_bit_cast(float, w.x & 0xffff0000u), f2 = __builtin_bit_cast(float, w.y << 16), f3 = __builtin_bit_cast(float, w.y & 0xffff0000u),
                            f4 = __builtin_bit_cast(float, w.z << 16), f5 = __builtin_bit_cast(float, w.z & 0xffff0000u), f6 = __builtin_bit_cast(float, w.w << 16), f7 = __builtin_bit_cast(float, w.w & 0xffff0000u);
                if (NEG) { sum[0] -= f0; sum[1] -= f1; sum[2] -= f2; sum[3] -= f3; sum[4] -= f4; sum[5] -= f5; sum[6] -= f6; sum[7] -= f7; } else { sum[0] += f0; sum[1] += f1; sum[2] += f2; sum[3] += f3; sum[4] += f4; sum[5] += f5; sum[6] += f6; sum[7] += f7; } };
            auto valid = [&](int q) -> bool { if (!EDGE) return true; const int p = n0 + q; return p >= 0 && p < nseq; };
            for (int q = r0 - hW; q < r0 + hW; ++q) if (valid(q)) acc8(rd(q), PoolC<0u>{});
            bf16_t* orow = MX + (size_t)(u.pm * BM + r0) * ldc + u.pn * BM + ch * 8;
#pragma unroll 4
            for (int t = r0; t < r0 + 16; ++t) {
                float inv;
                if (EDGE) { const int plo = n0 + t - hW, phi = n0 + t + hW; inv = 1.f / (float)((phi < nseq ? phi : nseq) - (plo > 0 ? plo : 0)); } else inv = 1.f / (float)W;
                const u32x4 sv = rd(t);
                u32x4 o; o.x = cvt_pk_bf16(sum[0] * inv - __builtin_bit_cast(float, sv.x << 16), sum[1] * inv - __builtin_bit_cast(float, sv.x & 0xffff0000u)); o.y = cvt_pk_bf16(sum[2] * inv - __builtin_bit_cast(float, sv.y << 16), sum[3] * inv - __builtin_bit_cast(float, sv.y & 0xffff0000u));
                o.z = cvt_pk_bf16(sum[4] * inv - __builtin_bit_cast(float, sv.z << 16), sum[5] * inv - __builtin_bit_cast(float, sv.z & 0xffff0000u)); o.w = cvt_pk_bf16(sum[6] * inv - __builtin_bit_cast(float, sv.w << 16), sum[7] * inv - __builtin_bit_cast(float, sv.w & 0xffff0000u));
                *(u32x4*)(orow + (size_t)(t - r0) * ldc) = o;
                if (valid(t - hW)) acc8(rd(t - hW), PoolC<1u>{});
                if (valid(t + hW)) acc8(rd(t + hW), PoolC<0u>{});
            }
        };
        if (tid < 448) strip_pool(1 + (tid >> 5), tid & 31, PoolC<0u>{});
        if (tid == 0) { unsigned sp = 0;
            while ((hasup && __hip_atomic_load(hcnt + (u.pm - 1) * 8 + u.pn, __ATOMIC_RELAXED, __HIP_MEMORY_SCOPE_AGENT) < 1u) || (hasdn && __hip_atomic_load(hcnt + (u.pm + 1) * 8 + u.pn, __ATOMIC_RELAXED, __HIP_MEMORY_SCOPE_AGENT) < 1u)) {
                __builtin_amdgcn_s_sleep(2); if (++sp > (1u << 22)) break; } }
        __syncthreads();
        { const int hrow = tid >> 5, ch = tid & 31; const bool up = hrow < 8;
          if (up ? hasup : hasdn) { const unsigned src = (unsigned)((up ? u.pm - 1 : u.pm + 1) * 8 + u.pn) * 8192u + (unsigned)((up ? hrow + 8 : hrow - 8) * 512 + ch * 16);
              *(PG8_LAS u32x4*)(HL + hrow * 512 + ch * 16) = __builtin_amdgcn_raw_buffer_load_b128(hrs, (int)src, 0, 16); } }
        __syncthreads();
        if (tid < 64) strip_pool((tid >> 5) ? 15 : 0, tid & 31, PoolC<1u>{});
    }
};
struct EpiSwiglu {
    static constexpr bool PERM = true, AFTER_DRAIN = false;
    bf16_t* H;
    __device__ __forceinline__ void operator()(const f32x4 (&acc)[2][2][4][2], const Unit& u, int wr, int wc, int fr, int fq) const {
        const int row0 = u.pm * BM + wr * 64 + fr, col0 = (u.pn & 3) * 128 + wc * 32 + 8 * fq;
#pragma unroll
        for (int ai = 0; ai < 2; ++ai)
#pragma unroll
            for (int m = 0; m < 4; ++m) { bf16_t* rowp = H + (size_t)(row0 + ai * HALF + m * 16) * 512 + col0;
                float h[8];
#pragma unroll
                for (int n = 0; n < 2; ++n)
#pragma unroll
                    for (int i = 0; i < 4; ++i) { const float a = acc[ai][0][m][n][i], b = acc[ai][1][m][n][i]; h[n * 4 + i] = a * __builtin_amdgcn_rcpf(1.f + __builtin_amdgcn_exp2f(-1.4426950408889634f * a)) * b; }
                u32x4 w; w.x = cvt_pk_bf16(h[0], h[1]); w.y = cvt_pk_bf16(h[2], h[3]); w.z = cvt_pk_bf16(h[4], h[5]); w.w = cvt_pk_bf16(h[6], h[7]);
                asm volatile("global_store_dwordx4 %0, %1, off sc1\n\ts_nop 1" :: "v"(rowp), "v"(w) : "memory"); }
    }
};
}
namespace pg8 {
__device__ __forceinline__ unsigned bimg(unsigned k, unsigned n) { return 512u * k + 16u * ((n >> 3) ^ (((k & 3u) << 2) | ((k >> 2) & 3u))) + 2u * (n & 7u); }
#define PG8_TR2(d0, d1, a0, a1, OFF) asm volatile("ds_read_b64_tr_b16 %0, %2 offset:" #OFF "\n\tds_read_b64_tr_b16 %1, %3 offset:" #OFF : "=&v"(d0), "=&v"(d1) : "v"(a0), "v"(a1) : "memory")
typedef unsigned short u16x4 __attribute__((ext_vector_type(4)));
__device__ __forceinline__ bf16x8 cat44(u16x4 lo, u16x4 hi) { bf16x8 r; r[0] = (short)lo[0]; r[1] = (short)lo[1]; r[2] = (short)lo[2]; r[3] = (short)lo[3]; r[4] = (short)hi[0]; r[5] = (short)hi[1]; r[6] = (short)hi[2]; r[7] = (short)hi[3]; return r; }

struct MoeCfg { const bf16_t* A; int lda; const int* arow; int K; const float* W0; const float* W1; int ldn; size_t estride; int colstep; int NT; };
struct FusedOrder {
    const PG8_LAS int* tab; int G, c, T;
    __device__ __forceinline__ void init(const PG8_LAS int* tab_, int G_, int c_) { tab = tab_; G = G_; c = c_; int t = 0; _Pragma("unroll 1") for (int e = 0; e < 32; ++e) t += tab[e]; T = t; }
    __device__ __forceinline__ bool unit(int L, int NT, Unit& u) const {
        int acc = 0, e = 0, n = 0;
#pragma unroll 1
        for (; e < 32; ++e) { n = tab[e]; if (L < NT * (acc + n)) break; acc += n; }
        if (e >= 32) return false;
        const int q = L - NT * acc, j = q / n, t = acc + (q - j * n);
        u.pm = t; u.pn = e * NT + j; return true;
    }
    __device__ __forceinline__ bool next(int i, Unit& u, int& type, int& kh, int& ub) const {
        const int nU = 4 * T, R0 = (nU + G - 1) / G; int nFull = nU;
        if (R0 > 1 && 2 * (nU - G * (R0 - 1)) <= G) nFull = G * (R0 - 1);
        const int nG1 = nFull + 2 * (nU - nFull), nG2 = 8 * T, R = (nG1 + G - 1) / G, nH = nG1 - G * (R - 1), nL = G - nH, CU = 3;
        const int n1 = (c < nG1) ? ((nG1 - 1 - c) / G + 1) : 0; const bool light = n1 < R;
        kh = -1; ub = 0;
        if (i < n1) { int L = c + G * i; type = 0;
            if (L >= nFull) { const int Lb = L - nFull; kh = Lb & 1; ub = Lb >> 1; L = nFull + ub; }
            return unit(L, 4, u); }
        const int i2 = i - n1; int u2;
        if (light && i2 < CU) u2 = i2 * nL + (c - nH); else u2 = CU * nL + c + G * (i2 - (light ? CU : 0));
        if (u2 >= nG2) return false;
        type = 1;
        return unit(u2, 8, u);
    }
};
template <int MODE, class EpiA, class EpiB>
__device__ __forceinline__ bool moe_run(PG8_LAS unsigned char* lds, const MoeCfg& c0, const MoeCfg& c1, unsigned* mcnt, unsigned char* xbuf, unsigned* xcnt, const FusedOrder& S, const EpiA& EA, const EpiB& EB,
                                        int& ui, Unit& cur, int& type, int& kh, int& ub) {
    typedef EpiA Epi;
    constexpr bool T1 = MODE == 2, SPLIT = MODE == 1;
#define F_SA(b, h) (((b) * 2 + (h)) * 8192)
#define F_SB(b) (32768 + (b) * 16384)
#define F_UNIFORM() do { cur.pm = __builtin_amdgcn_readfirstlane(cur.pm); cur.pn = __builtin_amdgcn_readfirstlane(cur.pn); type = __builtin_amdgcn_readfirstlane(type); kh = __builtin_amdgcn_readfirstlane(kh); ub = __builtin_amdgcn_readfirstlane(ub); } while (0)
    for (;;) {
        if ((type ? 2 : (kh >= 0 ? 1 : 0)) != MODE) return true;
    int tz_ = threadIdx.x; asm volatile("" : "+v"(tz_));
    const int tid = tz_, wid = __builtin_amdgcn_readfirstlane(tid >> 6), lane = tid & 63, wr = wid >> 2, wc = wid & 3, fr = lane & 15, fq = lane >> 4;
    int RA, CA; { const int b_ = tid * 16, st = b_ / 1024, sb = b_ % 1024, swz = sb ^ (((sb >> 9) & 1) << 5); RA = st * 16 + swz / 64; CA = (swz % 64) / 2; }
    const int aoff = ((wr * 64 + fr) >> 4) * 1024 + (((fr & 15) * 64 + fq * 16) ^ (((((fr & 15) * 64 + fq * 16) >> 9) & 1) << 5));
    const int n4 = tid & 63, kr = tid >> 6;
    int wcol; { const int a = n4 & 7, g32 = (n4 & 31) >> 3; wcol = Epi::PERM ? (32 * g32 + 8 * (a & 3) + 4 * (a >> 2)) : 4 * (n4 & 31); }
    const bool hi_half = n4 >= 32;
    unsigned bta[4];
    { const unsigned q = (lane & 15) >> 2, p = lane & 3, g = lane >> 4;
#pragma unroll
      for (int n = 0; n < 2; ++n)
#pragma unroll
          for (int t = 0; t < 2; ++t) { const unsigned row = 8 * g + 4 * t + q, ch = (unsigned)(32 * wc + 16 * n) / 8 + (p >> 1);
              bta[n * 2 + t] = 512u * row + 16u * (ch ^ (((row & 3u) << 2) | ((row >> 2) & 3u))) + 8u * (p & 1); } }
        const bf16_t* A = T1 ? c1.A : c0.A; const int lda = T1 ? c1.lda : c0.lda; const int* arow = T1 ? c1.arow : c0.arow; const int nst_all = (T1 ? c1.K : c0.K) / 32, nst = SPLIT ? nst_all / 2 : nst_all, kb = (SPLIT && kh > 0) ? nst : 0;
        const float* W0 = T1 ? c1.W0 : c0.W0; const float* W1 = T1 ? c1.W1 : c0.W1; const int ldn = T1 ? c1.ldn : c0.ldn; const size_t estride = T1 ? c1.estride : c0.estride; const int colstep = T1 ? c1.colstep : c0.colstep, NT = T1 ? c1.NT : c0.NT;
        if constexpr (T1) {
            if (tid == 0) { unsigned sp = 0; while (__hip_atomic_load(mcnt + cur.pm, __ATOMIC_RELAXED, __HIP_MEMORY_SCOPE_AGENT) < 4u) { __builtin_amdgcn_s_sleep(2); if (++sp > (1u << 22)) break; } }
            __syncthreads();
        }
        f32x4 acc[2][2][4][2];
#pragma unroll
        for (int x = 0; x < 2; ++x)
#pragma unroll
            for (int y = 0; y < 2; ++y)
#pragma unroll
                for (int m = 0; m < 4; ++m)
#pragma unroll
                    for (int n = 0; n < 2; ++n) acc[x][y][m][n] = (f32x4){0.f, 0.f, 0.f, 0.f};
        unsigned ao[2];
#pragma unroll
        for (int h = 0; h < 2; ++h) { const int r = cur.pm * BM + h * HALF + RA; int srow = r;
            if (arow) { srow = arow[r]; srow = ((unsigned)srow < 8192u) ? srow : 0; }
            ao[h] = ((unsigned)srow * (unsigned)lda + (unsigned)CA) * 2u + (unsigned)kb * 64u; }
        const int e = cur.pn / NT, j = cur.pn - e * NT;
        const float* wp = (hi_half ? W1 : W0) + (size_t)e * estride + (size_t)j * colstep + wcol + ((size_t)kr + (size_t)kb * 32) * ldn;
        const __amdgpu_buffer_rsrc_t hrs = __builtin_amdgcn_make_buffer_rsrc((void*)c1.A, 0, 0x7fffffff, 0x00020000);
        f32x4 wv0[4], wv1[4]; u32x4 av0[2], av1[2];
#define F_ISSUE(AV, WV, kt) do { if constexpr (T1) { _Pragma("unroll") for (int h = 0; h < 2; ++h) AV[h] = __builtin_amdgcn_raw_buffer_load_b128(hrs, (int)(ao[h] + (unsigned)(kt) * 64u), 0, 16); } \
            else { _Pragma("unroll") for (int h = 0; h < 2; ++h) AV[h] = *(const __attribute__((address_space(1))) u32x4*)((const char*)A + (ao[h] + (unsigned)(kt) * 64u)); } \
            _Pragma("unroll") for (int i = 0; i < 4; ++i) WV[i] = *(const __attribute__((address_space(1))) f32x4*)(wp + ((size_t)(kt) * 32 + 8 * i) * ldn); } while (0)
#define F_WRITE(AV, WV, b) do { _Pragma("unroll") for (int h = 0; h < 2; ++h) *(PG8_LAS u32x4*)(lds + F_SA(b, h) + tid * 16) = AV[h]; \
            _Pragma("unroll") for (int i = 0; i < 4; ++i) { typedef unsigned u32x2 __attribute__((ext_vector_type(2))); \
            *(PG8_LAS u32x2*)(lds + F_SB(b) + bimg(kr + 8 * i, 4 * n4)) = (u32x2){cvt_pk_bf16(WV[i][0], WV[i][1]), cvt_pk_bf16(WV[i][2], WV[i][3])}; } } while (0)
#define F_COMPUTE(b) do { const unsigned bb = (unsigned)(size_t)(lds + F_SB(b)); \
            _Pragma("unroll") for (int bj = 0; bj < 2; ++bj) { typedef short s16x4 __attribute__((ext_vector_type(4))); \
                const s16x4 d0 = __builtin_amdgcn_ds_read_tr16_b64_v4i16((PG8_LAS s16x4*)(size_t)(bb + bta[0] + 256 * bj)), d1 = __builtin_amdgcn_ds_read_tr16_b64_v4i16((PG8_LAS s16x4*)(size_t)(bb + bta[1] + 256 * bj)); \
                const s16x4 d2 = __builtin_amdgcn_ds_read_tr16_b64_v4i16((PG8_LAS s16x4*)(size_t)(bb + bta[2] + 256 * bj)), d3 = __builtin_amdgcn_ds_read_tr16_b64_v4i16((PG8_LAS s16x4*)(size_t)(bb + bta[3] + 256 * bj)); \
                const bf16x8 B0 = __builtin_shufflevector(d0, d1, 0, 1, 2, 3, 4, 5, 6, 7), B1 = __builtin_shufflevector(d2, d3, 0, 1, 2, 3, 4, 5, 6, 7); \
                _Pragma("unroll") for (int ai = 0; ai < 2; ++ai) { bf16x8 Af[4]; \
                    _Pragma("unroll") for (int m = 0; m < 4; ++m) Af[m] = *(const PG8_LAS bf16x8*)(lds + F_SA(b, ai) + aoff + m * 1024); \
                    __builtin_amdgcn_s_setprio(1); \
                    _Pragma("unroll") for (int m = 0; m < 4; ++m) { acc[ai][bj][m][0] = __builtin_amdgcn_mfma_f32_16x16x32_bf16(B0, Af[m], acc[ai][bj][m][0], 0, 0, 0); \
                                                                     acc[ai][bj][m][1] = __builtin_amdgcn_mfma_f32_16x16x32_bf16(B1, Af[m], acc[ai][bj][m][1], 0, 0, 0); } \
                    __builtin_amdgcn_s_setprio(0); } } } while (0)
#define F_SYNC() do { asm volatile("s_waitcnt lgkmcnt(0)" ::: "memory"); __builtin_amdgcn_s_barrier(); } while (0)
        F_ISSUE(av0, wv0, 0); F_ISSUE(av1, wv1, 1);
        F_WRITE(av0, wv0, 0);
        F_SYNC();
        for (int t = 0; t < nst; t += 2) {
            F_ISSUE(av0, wv0, (t + 2 < nst) ? t + 2 : nst - 1);
            __builtin_amdgcn_sched_barrier(0);
            F_COMPUTE(0);
            __builtin_amdgcn_sched_barrier(0);
            F_WRITE(av1, wv1, 1);
            asm volatile("s_waitcnt lgkmcnt(0)" ::: "memory"); __builtin_amdgcn_s_barrier();
            F_ISSUE(av1, wv1, (t + 3 < nst) ? t + 3 : nst - 1);
            __builtin_amdgcn_sched_barrier(0);
            F_COMPUTE(1);
            __builtin_amdgcn_sched_barrier(0);
            F_WRITE(av0, wv0, 0);
            asm volatile("s_waitcnt lgkmcnt(0)" ::: "memory"); __builtin_amdgcn_s_barrier();
        }
        if constexpr (SPLIT) {
            const unsigned xo = (unsigned)tid * 16u;
            const __amdgpu_buffer_rsrc_t xrs = __builtin_amdgcn_make_buffer_rsrc((void*)(xbuf + (size_t)ub * 1048576), 0, 1048576, 0x00020000);
            const int hb = kh * 524288;
#pragma unroll
            for (int x = 0; x < 2; ++x)
#pragma unroll
                for (int y = 0; y < 2; ++y)
#pragma unroll
                    for (int m = 0; m < 4; ++m)
#pragma unroll
                        for (int n = 0; n < 2; ++n) __builtin_amdgcn_raw_buffer_store_b128(__builtin_bit_cast(u32x4, acc[x][y][m][n]), xrs, (int)xo, hb + (((x * 2 + y) * 4 + m) * 2 + n) * 8192, 16);
            asm volatile("s_waitcnt vmcnt(0)" ::: "memory"); __syncthreads();
            if (tid == 0) __hip_atomic_fetch_add(xcnt + ub, 1u, __ATOMIC_RELAXED, __HIP_MEMORY_SCOPE_AGENT);
            if (kh == 1) {
                if (tid == 0) { unsigned sp = 0; while (__hip_atomic_load(xcnt + ub, __ATOMIC_RELAXED, __HIP_MEMORY_SCOPE_AGENT) < 2u) { __builtin_amdgcn_s_sleep(2); if (++sp > (1u << 22)) break; } }
                __syncthreads();
                const int row0 = cur.pm * BM + wr * 64 + fr, col0 = (cur.pn & 3) * 128 + wc * 32 + 8 * fq;
#pragma unroll 1
                for (int am = 0; am < 8; ++am) { const int ai = am >> 2, m = am & 3;
                    f32x4 pa[2][2], pb[2][2];
#pragma unroll
                    for (int n = 0; n < 2; ++n)
#pragma unroll
                        for (int hf = 0; hf < 2; ++hf) { pa[n][hf] = __builtin_bit_cast(f32x4, __builtin_amdgcn_raw_buffer_load_b128(xrs, (int)xo, hf * 524288 + (((ai * 2 + 0) * 4 + m) * 2 + n) * 8192, 16));
                                                          pb[n][hf] = __builtin_bit_cast(f32x4, __builtin_amdgcn_raw_buffer_load_b128(xrs, (int)xo, hf * 524288 + (((ai * 2 + 1) * 4 + m) * 2 + n) * 8192, 16)); }
                    float h[8];
#pragma unroll
                    for (int n = 0; n < 2; ++n)
#pragma unroll
                        for (int i = 0; i < 4; ++i) { const float ga = pa[n][0][i] + pa[n][1][i], gb = pb[n][0][i] + pb[n][1][i]; h[n * 4 + i] = ga * __builtin_amdgcn_rcpf(1.f + __builtin_amdgcn_exp2f(-1.4426950408889634f * ga)) * gb; }
                    u32x4 w; w.x = cvt_pk_bf16(h[0], h[1]); w.y = cvt_pk_bf16(h[2], h[3]); w.z = cvt_pk_bf16(h[4], h[5]); w.w = cvt_pk_bf16(h[6], h[7]);
                    bf16_t* rowp = EA.H + (size_t)(row0 + ai * HALF + m * 16) * 512 + col0;
                    asm volatile("global_store_dwordx4 %0, %1, off sc1\n\ts_nop 1" :: "v"(rowp), "v"(w) : "memory"); }
                asm volatile("s_waitcnt vmcnt(0)" ::: "memory"); __syncthreads();
                if (tid == 0) __hip_atomic_fetch_add(mcnt + cur.pm, 1u, __ATOMIC_RELAXED, __HIP_MEMORY_SCOPE_AGENT); }
        } else if constexpr (!T1) {
            EA(acc, cur, wr, wc, fr, fq);
            asm volatile("s_waitcnt vmcnt(0)" ::: "memory"); __syncthreads();
            if (tid == 0) __hip_atomic_fetch_add(mcnt + cur.pm, 1u, __ATOMIC_RELAXED, __HIP_MEMORY_SCOPE_AGENT); }
        else EB(acc, cur, wr, wc, fr, fq);
        ++ui;
        if (!S.next(ui, cur, type, kh, ub)) return false;
        F_UNIFORM();
    }
#undef F_UNIFORM
#undef F_SA
#undef F_SB
#undef F_ISSUE
#undef F_WRITE
#undef F_COMPUTE
#undef F_SYNC
}
template <class EpiA, class EpiB>
__device__ __forceinline__ void gemm_moe_fused(PG8_LAS unsigned char* lds, const MoeCfg c0, const MoeCfg c1, unsigned* mcnt, unsigned char* xbuf, unsigned* xcnt, const FusedOrder& S, const EpiA& EA, const EpiB& EB) {
    Unit cur; int ui = 0, type = 0, kh = -1, ub = 0;
    if (!S.next(0, cur, type, kh, ub)) return;
    cur.pm = __builtin_amdgcn_readfirstlane(cur.pm); cur.pn = __builtin_amdgcn_readfirstlane(cur.pn); type = __builtin_amdgcn_readfirstlane(type); kh = __builtin_amdgcn_readfirstlane(kh); ub = __builtin_amdgcn_readfirstlane(ub);
    if (!moe_run<0, EpiA, EpiB>(lds, c0, c1, mcnt, xbuf, xcnt, S, EA, EB, ui, cur, type, kh, ub)) return;
    if (!moe_run<1, EpiA, EpiB>(lds, c0, c1, mcnt, xbuf, xcnt, S, EA, EB, ui, cur, type, kh, ub)) return;
    (void)moe_run<2, EpiA, EpiB>(lds, c0, c1, mcnt, xbuf, xcnt, S, EA, EB, ui, cur, type, kh, ub);
}
}
constexpr int D = 2048, SEQ = 4096, NTOK = 8192, CTXL = 256, NCTX = 512, MROWS = NTOK + NCTX;
constexpr int MIXW = 7168;
constexpr int C_Q = 0, C_K = 1024, C_V = 1536, C_HQ = 2048, C_FF = 3072, C_FB = 4096, C_HI = 5120, C_HG = 6144;
constexpr int NEXP = 32, FF = 512;
constexpr float ALPHA = 1.41421356237309515f, LN_EPS = 1e-5f, NORM_EPS = 1e-6f;
constexpr int NWAVES = 8, NTHR = 512;
constexpr int XEROWS = 2 * NTOK + NEXP * 256;
constexpr size_t MiB = 1u << 20;
constexpr size_t WS_CTL = 0, CTL_ZERO_BYTES = 1 * MiB;
constexpr size_t WS_SMALL = 1 * MiB;
constexpr size_t WS_WIN = 4 * MiB;
constexpr size_t WS_WOUT = WS_WIN + (size_t)MIXW * D * 2;
constexpr size_t WS_WPIN = WS_WOUT + (size_t)D * D * 2;
constexpr size_t WS_WPOUT = WS_WPIN + (size_t)D * D * 2;
constexpr size_t WS_WGRP = WS_WPOUT + (size_t)D * D * 2;
constexpr size_t WS_W13 = WS_WGRP + (size_t)4 * 512 * 512 * 2;
constexpr size_t WS_W16 = WS_W13;
constexpr size_t WS_WFOLD = WS_W13 + 1 * MiB;
constexpr size_t WS_HALO = WS_W13 + 16 * MiB;
constexpr size_t WS_XBUF = WS_W13 + 32 * MiB;
constexpr size_t WS_W2 = WS_W13 + (size_t)2 * NEXP * 1024 * D * 2;
constexpr size_t WS_REGA = WS_W2 + (size_t)2 * NEXP * D * FF * 2;
constexpr size_t REGA_BYTES = (size_t)MROWS * MIXW * 2;
constexpr size_t WS_REGB = WS_REGA + REGA_BYTES;
constexpr size_t REGB_BYTES = (size_t)XEROWS * D * 2;
constexpr size_t WS_HX = WS_REGB + REGB_BYTES;
constexpr size_t WS_CAT = WS_HX + (size_t)MROWS * D * 2;
constexpr size_t WS_H = WS_CAT + (size_t)NTOK * D * 2;
constexpr size_t WS_YX = WS_H + (size_t)XEROWS * FF * 2;
constexpr size_t WS_X1 = WS_YX + (size_t)NTOK * D * 4;
constexpr size_t WS_X2 = WS_X1 + (size_t)NTOK * D * 4;
constexpr size_t WS_TOK = WS_X2 + (size_t)NTOK * D * 4;
constexpr size_t WS_END = WS_TOK + (size_t)NTOK * D * 2;
static_assert(WS_XBUF + (size_t)248 * 1048576 <= WS_REGA, "xbuf");
static_assert((size_t)XEROWS * D * 2 <= REGA_BYTES && (size_t)3 * NTOK * D * 2 <= REGA_BYTES && (size_t)2 * NTOK * 1024 * 4 <= REGB_BYTES, "aliases");
constexpr int CW_TMO = 0, CW_CNT = 64, CW_BAR = 4096, CW_MCNT = 200000  , CW_GVQ = 203584  , CW_HCNT = 203136  , CW_XCNT = 202048  , CW_INARR = 201024  ;
constexpr int SM_MOD = 0;
constexpr int SM_MC = SM_MOD + 2 * 2 * 6 * D;
constexpr int SM_LB = SM_MC + 6 * D;
constexpr int SM_TOKE = SM_LB + 2 * 1024;
constexpr int SM_TOKR = SM_TOKE + 2 * NTOK;
constexpr int SM_TOKG = SM_TOKR + 2 * NTOK;
constexpr int SM_TOKS = SM_TOKG + 2 * NTOK;
constexpr int SM_BCNT = SM_TOKS + 2 * NTOK;
constexpr int SM_SLOTTOK = SM_BCNT + 2 * 256 * 32;
constexpr int SM_END = SM_SLOTTOK + XEROWS;
static_assert((size_t)SM_END * 4 <= 3 * MiB, "small");
constexpr int RING_BYTES = 131072, LDS_CTLB = 162816  , LDS_TAB = LDS_CTLB  , LDS_MISC = LDS_CTLB + 512, LDS_BYTES = 163840;

#define GAS __attribute__((address_space(1)))
#define LAS __attribute__((address_space(3)))
typedef unsigned short bf16;
typedef unsigned v4u __attribute__((ext_vector_type(4)));
typedef unsigned v2u __attribute__((ext_vector_type(2)));
typedef float f32x4 __attribute__((ext_vector_type(4)));
typedef float f32x2v __attribute__((ext_vector_type(2)));
#define LDS_WAIT() asm volatile("s_waitcnt lgkmcnt(0)" ::: "memory")
#define VM_WAIT() asm volatile("s_waitcnt vmcnt(0)" ::: "memory")
__device__ __forceinline__ unsigned f2bf(float f) { unsigned u = __builtin_bit_cast(unsigned, f); return (u + 0x7fffu + ((u >> 16) & 1u)) >> 16; }
__device__ __forceinline__ unsigned pk2(float lo, float hi) { return f2bf(lo) | (f2bf(hi) << 16); }
__device__ __forceinline__ float bf2f(unsigned h) { return __builtin_bit_cast(float, h << 16); }
__device__ __forceinline__ float bflo(unsigned w) { return __builtin_bit_cast(float, w << 16); }
__device__ __forceinline__ float bfhi(unsigned w) { return __builtin_bit_cast(float, w & 0xffff0000u); }
__device__ __forceinline__ float sigmoid_f(float x) { return 1.f / (1.f + expf(-x)); }
__device__ __forceinline__ float silu_f(float x) { return x / (1.f + expf(-x)); }
__device__ __forceinline__ float fsigmoid(float x) { return __builtin_amdgcn_rcpf(1.f + __builtin_amdgcn_exp2f(-1.4426950408889634f * x)); }
__device__ __forceinline__ float fsilu(float x) { return x * fsigmoid(x); }
__device__ __forceinline__ float wave_sum(float v) {
    v += __builtin_bit_cast(float, __builtin_amdgcn_update_dpp(0, __builtin_bit_cast(int, v), 0xB1, 0xf, 0xf, true));
    v += __builtin_bit_cast(float, __builtin_amdgcn_update_dpp(0, __builtin_bit_cast(int, v), 0x4E, 0xf, 0xf, true));
    v += __builtin_bit_cast(float, __builtin_amdgcn_update_dpp(0, __builtin_bit_cast(int, v), 0x141, 0xf, 0xf, true));
    v += __builtin_bit_cast(float, __builtin_amdgcn_update_dpp(0, __builtin_bit_cast(int, v), 0x140, 0xf, 0xf, true));
    v += __builtin_bit_cast(float, __builtin_amdgcn_update_dpp(0, __builtin_bit_cast(int, v), 0x142, 0xa, 0xf, false));
    v += __builtin_bit_cast(float, __builtin_amdgcn_update_dpp(0, __builtin_bit_cast(int, v), 0x143, 0xc, 0xf, false));
    return __builtin_bit_cast(float, __builtin_amdgcn_readlane(__builtin_bit_cast(int, v), 63));
}
#define XB_TMO      128
#define XB_XCNT(j)  (256  + 64 * (j))
#define XB_XSUB(j)  (1280 + 64 * (j))
#define XB_XGEN(j)  (2304 + 64 * (j))
#define XB_TOP      3328
#define XB_TOPGEN   3392
#define XCD_BAR_WORDS 3456
#define XB_SPIN_CAP (1u << 18)

__device__ __forceinline__ unsigned xb_ld(unsigned* p)              { return __hip_atomic_load(p, __ATOMIC_RELAXED, __HIP_MEMORY_SCOPE_AGENT); }
__device__ __forceinline__ unsigned xb_add(unsigned* p, unsigned v) { return __hip_atomic_fetch_add(p, v, __ATOMIC_RELAXED, __HIP_MEMORY_SCOPE_AGENT); }
__device__ __forceinline__ unsigned xb_xcc_id() { return (unsigned)__builtin_amdgcn_s_getreg((3 << 11) | 20) & 0xFu; }
#define XB_SPIN(cond, bar) do { unsigned _sp = 0; while (cond) { __builtin_amdgcn_s_sleep(1); \
    if ((++_sp & 255u) == 0u) { if (xb_ld(&(bar)[XB_TMO])) break; if (_sp > XB_SPIN_CAP) { atomicAdd(&(bar)[XB_TMO], 1u); break; } } } } while (0)

struct XcdBarrier {
    unsigned* bar; unsigned x;
    volatile LAS unsigned* st;
};

__device__ __forceinline__ XcdBarrier xcd_barrier_post(unsigned* bar, volatile LAS unsigned* st) {
    XcdBarrier b; b.bar = bar; b.x = xb_xcc_id(); b.st = st;
    if (threadIdx.x == 0) (void)xb_add(&bar[XB_XCNT(b.x)], 1u);
    return b;
}
__device__ __forceinline__ void xcd_barrier_complete(unsigned* bar, unsigned x, unsigned& nloc, unsigned& nx) {
    const unsigned G = gridDim.x * gridDim.y * gridDim.z;
    unsigned sum, cnt, mine, sp = 0u;
    for (;;) {
        sum = 0u; cnt = 0u; mine = 0u;
#pragma unroll
        for (unsigned j = 0; j < 16; ++j) { const unsigned c = xb_ld(&bar[XB_XCNT(j)]); sum += c; cnt += (c > 0u) ? 1u : 0u; mine = (j == x) ? c : mine; }
        if (sum == G) break;
        __builtin_amdgcn_s_sleep(1);
        if ((++sp & 255u) == 0u) { if (xb_ld(&bar[XB_TMO])) break; if (sp > XB_SPIN_CAP) { atomicAdd(&bar[XB_TMO], 1u); break; } }
    }
    nloc = mine > 0u ? mine : 1u; nx = cnt > 0u ? cnt : 1u;
}

__device__ __forceinline__ void xcd_barrier(const XcdBarrier& b) {
    asm volatile("s_waitcnt vmcnt(0)" ::: "memory");
    __syncthreads();
    if (threadIdx.x == 0) {
        unsigned* bar = b.bar;
        __builtin_amdgcn_s_waitcnt(0);
        unsigned nloc = b.st[0], nx = b.st[1];
        if (nloc == 0u) { xcd_barrier_complete(bar, b.x, nloc, nx); b.st[0] = nloc; b.st[1] = nx; }
        const unsigned old = xb_add(&bar[XB_XSUB(b.x)], 1u);
        const unsigned gen = old / nloc;
        if (old + 1u == (gen + 1u) * nloc) {
            __builtin_amdgcn_fence(__ATOMIC_RELEASE, "agent");
            asm volatile("s_waitcnt vmcnt(0)" ::: "memory");
            const unsigned og = xb_add(&bar[XB_TOP], 1u);
            const unsigned tg = og / nx;
            if (og + 1u == (tg + 1u) * nx) xb_add(&bar[XB_TOPGEN], 1u);
            else XB_SPIN(xb_ld(&bar[XB_TOPGEN]) == tg, bar);
            __builtin_amdgcn_fence(__ATOMIC_ACQUIRE, "agent");
            xb_add(&bar[XB_XGEN(b.x)], 1u);
            asm volatile("s_waitcnt vmcnt(0)" ::: "memory");
        } else {
            XB_SPIN(xb_ld(&bar[XB_XGEN(b.x)]) == gen, bar);
            __builtin_amdgcn_fence(__ATOMIC_ACQUIRE, "agent");
            asm volatile("s_waitcnt vmcnt(0)" ::: "memory");
        }
    }
    __syncthreads();
}
struct Args { const float* in[24]; float* out; unsigned char* ws; int ph_lo, ph_hi; };
struct Ctx {
    LAS unsigned char* lds; int tid, lane, wave, vcu, G;
};

__device__ __forceinline__ void tr_item(const float* W, int K, int N, bf16* WT, int k0, int n0, int drow0, LAS float* scr, int lane, bool rperm = false) {
    const int kr = lane >> 4, n4 = (lane & 15) * 4;
#pragma unroll 8
    for (int i = 0; i < 16; ++i) { const int kk = 4 * i + kr; const f32x4 v = *(const GAS f32x4*)(W + (size_t)(k0 + kk) * N + n0 + n4);
        LAS float* s = scr + kk * 65 + n4; s[0] = v[0]; s[1] = v[1]; s[2] = v[2]; s[3] = v[3]; }
    LDS_WAIT();
    const int c = lane & 7;
#pragma unroll
    for (int j = 0; j < 8; ++j) { const int n = (lane >> 3) + 8 * j, ns = rperm ? (4 * (n >> 3) + (n & 3) + 32 * ((n >> 2) & 1)) : n; const LAS float* s = scr + (8 * c) * 65 + ns;
        v4u o; o.x = pk2(s[0 * 65], s[1 * 65]); o.y = pk2(s[2 * 65], s[3 * 65]); o.z = pk2(s[4 * 65], s[5 * 65]); o.w = pk2(s[6 * 65], s[7 * 65]);
        *(GAS v4u*)(WT + (size_t)(drow0 + n) * K + k0 + 8 * c) = o; }
    LDS_WAIT();
}
__device__ __forceinline__ void p0_convert(const Ctx& F, const Args& a, int me, int nb, bool late, int gemv_wgs = 0) {
    unsigned char* ws = a.ws;
    LAS float* scr = (LAS float*)(F.lds + F.wave * 16640);
    const int gw = me * NWAVES + F.wave, NGW = nb * NWAVES;
    constexpr int I_IN = 32 * (MIXW / 64), I_SQ = 32 * 32, I_GRP = 4 * 64, I_MOE = 64 * 768;
    constexpr int NITEMS = I_IN + 1 * I_SQ + I_GRP;
    if (me < 0 || me >= nb) return;
    if (late) { for (int r = gw; r < I_SQ; r += NGW) tr_item(a.in[13], D, D, (bf16*)(ws + WS_WPIN), 64 * (r / 32), 64 * (r % 32), 64 * (r % 32), scr, F.lane); return; }
    if (gemv_wgs < 0) {
        for (int r = gw; r < I_SQ; r += NGW) tr_item(a.in[12], D, D, (bf16*)(ws + WS_WOUT), 64 * (r / 32), 64 * (r % 32), 64 * (r % 32), scr, F.lane); return; }
    const int gb = gemv_wgs < nb ? gemv_wgs : nb, shares = me < gb ? 1 : 2, vbase = me < gb ? me * NWAVES : gb * NWAVES + (me - gb) * 2 * NWAVES, vtot = gb * NWAVES + (nb - gb) * 2 * NWAVES;
    for (int sh = 0; sh < shares; ++sh)
    for (int it = vbase + sh * NWAVES + F.wave; it < NITEMS; it += vtot) {
        int r = it;
        if (r < I_IN) { const int nb = MIXW / 64; tr_item(a.in[8], D, MIXW, (bf16*)(ws + WS_WIN), 64 * (r / nb), 64 * (r % nb), 64 * (r % nb), scr, F.lane, 64 * (r % nb) < C_V); continue; } r -= I_IN;
        if (r < I_SQ) { tr_item(a.in[16], D, D, (bf16*)(ws + WS_WPOUT), 64 * (r / 32), 64 * (r % 32), 64 * (r % 32), scr, F.lane); continue; } r -= I_SQ;
        if (r < I_GRP) { const int g = r / 64, ii = r % 64, c0 = 64 * (ii / 8), j0 = 64 * (ii % 8) + 4 * (F.lane & 15);
            const f32x4 sc = *(const GAS f32x4*)(a.in[15] + 512 * g + j0);
#pragma unroll 4
            for (int i = 0; i < 16; ++i) { const size_t e = ((size_t)g * 512 + c0 + 4 * i + (F.lane >> 4)) * 512 + j0; const f32x4 v = *(const GAS f32x4*)(a.in[14] + e) * sc;
                *(GAS v2u*)((bf16*)(ws + WS_WGRP) + e) = (v2u){pk2(v[0], v[1]), pk2(v[2], v[3])}; }
            continue; } r -= I_GRP;
        { const int le = r / 768, q = r % 768, which = q / 256, ii = q % 256;
          if (which < 2) { const int n0 = 64 * (ii % 8), drow0 = 256 * (n0 / 128) + (n0 % 128) + (which ? 128 : 0);
              tr_item(a.in[which ? 22 : 21] + (size_t)le * D * FF, D, FF, (bf16*)(ws + WS_W13) + (size_t)le * 1024 * D, 64 * (ii / 8), n0, drow0, scr, F.lane); }
          else tr_item(a.in[23] + (size_t)le * FF * D, FF, D, (bf16*)(ws + WS_W2) + (size_t)le * D * FF, 64 * (ii / 32), 64 * (ii % 32), 64 * (ii % 32), scr, F.lane); }
    }
}
__device__ __forceinline__ void p0_router_frags(const Ctx& F, const Args& a) {
    typedef _Float16 f16x8 __attribute__((ext_vector_type(8)));
    GAS f16x8* out = (GAS f16x8*)(a.ws + WS_W16);
    for (int i = F.vcu * NTHR + F.tid; i < 2 * 128 * 2 * 64; i += F.G * NTHR) {
        const int lane = i & 63, nt = (i >> 6) & 1, ks = (i >> 7) & 127, layer = i >> 14, col = 32 * nt + (lane & 31), k0 = 16 * ks + 8 * (lane >> 5);
        f16x8 v;
#pragma unroll
        for (int j = 0; j < 8; ++j) { float x = 0.f; if (col < 32) x = a.in[19][((size_t)layer * D + k0 + j) * 32 + col]; else if (col < 36) x = a.in[17][((size_t)layer * D + k0 + j) * 4 + (col - 32)]; v[j] = (_Float16)x; }
        out[i] = v;
    }
}
__device__ __forceinline__ void p0_mod(const Ctx& F, const Args& a, int u_lo, int u_hi, int me, int nb, bool with_lb, unsigned* queue = nullptr) {
    float* sm = (float*)(a.ws + WS_SMALL);
    LAS float* sv = (LAS float*)F.lds;
    LAS float* part = sv + 3 * D;
    for (int k = F.tid; k < D; k += NTHR) { sv[k] = silu_f(a.in[1][k]); sv[D + k] = silu_f(a.in[1][D + k]); sv[2 * D + k] = silu_f(a.in[3][k]); }
    __syncthreads();
    if (me < 0 || me >= nb) return;
    LAS int* qslot = (LAS int*)(part + 32 * 192);
    for (int u = u_lo + me; ; u += nb) {
        if (queue) { __syncthreads(); if (F.tid == 0) *qslot = (int)__hip_atomic_fetch_add(queue, 1u, __ATOMIC_RELAXED, __HIP_MEMORY_SCOPE_AGENT); __syncthreads(); u = u_lo + *qslot; }
        if (u >= u_hi) break;
        const int l = u / 192, col0 = (u % 192) * 64;
        const int sub = F.lane >> 4, q = F.lane & 15, slot = F.wave * 4 + sub;
        f32x4 a0 = {0.f, 0.f, 0.f, 0.f}, a1 = a0, a2 = a0;
        { const float* w = a.in[4] + (size_t)l * D * 6 * D + col0 + 4 * q;
#pragma unroll 8
            for (int r = slot; r < D; r += 32) { const f32x4 v = *(const GAS f32x4*)(w + (size_t)r * 6 * D); a0 += v * sv[r]; a1 += v * sv[D + r]; a2 += v * sv[2 * D + r]; }
            LAS float* p = part + slot * 192 + 4 * q;
            *(LAS f32x4*)p = a0; *(LAS f32x4*)(p + 64) = a1; *(LAS f32x4*)(p + 128) = a2;
        }
        __syncthreads();
        if (F.tid < 192) { float s = 0.f;
#pragma unroll
            for (int i = 0; i < 32; ++i) s += part[i * 192 + F.tid];
            const int v = F.tid >> 6, j = col0 + (F.tid & 63); s += a.in[5][l * 6 * D + j];
            if (v < 2) sm[SM_MOD + (l * 2 + v) * 6 * D + j] = s; else if (l == 0) sm[SM_MC + j] = s; }
        __syncthreads();
    }
    if (with_lb) for (int i = me * NTHR + F.tid; i < 2048; i += nb * NTHR) {
        const int dir = i >> 10, k = i & 1023; const float* hl = a.in[10];
        const float x0 = hl[(dir * 3 + 0) * 1024 + k], x1 = hl[(dir * 3 + 1) * 1024 + k], x2 = hl[(dir * 3 + 2) * 1024 + k];
        const float m = fmaxf(x0, fmaxf(x1, x2)), e0 = expf(x0 - m), e1 = expf(x1 - m), e2 = expf(x2 - m);
        sm[SM_LB + i] = e0 / (e0 + e1 + e2);
    }
}
__device__ __forceinline__ void p1_modulate(const Ctx& F, const Args& a) {
    const float* sm = (const float*)(a.ws + WS_SMALL); bf16* HX = (bf16*)(a.ws + WS_HX);
#pragma unroll 4
    for (int i = F.vcu * NTHR + F.tid; i < MROWS * (D / 8); i += F.G * NTHR) {
        const int t = i >> 8, d = (i & 255) * 8;
        const float* src; const float* sh; const float* sc;
        if (t < NTOK) { src = a.in[0] + (size_t)t * D + d; sh = sm + SM_MOD + (t / SEQ) * 6 * D + d; sc = sh + D; }
        else { src = a.in[2] + (size_t)(t - NTOK) * D + d; sh = sm + SM_MC + d; sc = sh + D; }
        const f32x4 x0 = *(const GAS f32x4*)src, x1 = *(const GAS f32x4*)(src + 4), h0 = *(const GAS f32x4*)sh, h1 = *(const GAS f32x4*)(sh + 4), c0 = *(const GAS f32x4*)sc, c1 = *(const GAS f32x4*)(sc + 4);
        const f32x4 y0 = x0 * (c0 + 1.f) + h0, y1 = x1 * (c1 + 1.f) + h1;
        v4u o; o.x = pk2(y0[0], y0[1]); o.y = pk2(y0[2], y0[3]); o.z = pk2(y1[0], y1[1]); o.w = pk2(y1[2], y1[3]);
        *(GAS v4u*)(HX + (size_t)t * D + d) = o;
    }
}
typedef short bf16x8_t __attribute__((ext_vector_type(8)));
typedef float f32x16 __attribute__((ext_vector_type(16)));
typedef unsigned short u16x4_t __attribute__((ext_vector_type(4)));
__device__ __forceinline__ unsigned offb(unsigned row, unsigned ch) { return 256u * row + 16u * (ch ^ (((row & 3u) << 2) | ((row >> 2) & 3u))); }
__device__ __forceinline__ unsigned cvtpk(float lo, float hi) { unsigned r; asm volatile("v_cvt_pk_bf16_f32 %0, %1, %2" : "=v"(r) : "v"(lo), "v"(hi)); return r; }
#define TR8(d0, d1, d2, d3, d4, d5, d6, d7, a0, a1, a2, a3, a4, a5, a6, a7, OFF) \
    asm volatile("ds_read_b64_tr_b16 %0, %8 offset:" #OFF "\n\tds_read_b64_tr_b16 %1, %9 offset:" #OFF "\n\tds_read_b64_tr_b16 %2, %10 offset:" #OFF "\n\tds_read_b64_tr_b16 %3, %11 offset:" #OFF "\n\t" \
                 "ds_read_b64_tr_b16 %4, %12 offset:" #OFF "\n\tds_read_b64_tr_b16 %5, %13 offset:" #OFF "\n\tds_read_b64_tr_b16 %6, %14 offset:" #OFF "\n\tds_read_b64_tr_b16 %7, %15 offset:" #OFF "\n\ts_waitcnt lgkmcnt(0)" \
                 : "=&v"(d0), "=&v"(d1), "=&v"(d2), "=&v"(d3), "=&v"(d4), "=&v"(d5), "=&v"(d6), "=&v"(d7) : "v"(a0), "v"(a1), "v"(a2), "v"(a3), "v"(a4), "v"(a5), "v"(a6), "v"(a7) : "memory")
__device__ __forceinline__ bf16x8_t cat4(u16x4_t lo, u16x4_t hi) { bf16x8_t r; r[0] = (short)lo[0]; r[1] = (short)lo[1]; r[2] = (short)lo[2]; r[3] = (short)lo[3]; r[4] = (short)hi[0]; r[5] = (short)hi[1]; r[6] = (short)hi[2]; r[7] = (short)hi[3]; return r; }

typedef short s16x4_t __attribute__((ext_vector_type(4)));
__device__ __forceinline__ bf16x8_t trd2(unsigned a0, unsigned a1) {
    const s16x4_t lo = __builtin_amdgcn_ds_read_tr16_b64_v4i16((LAS s16x4_t*)(size_t)a0), hi = __builtin_amdgcn_ds_read_tr16_b64_v4i16((LAS s16x4_t*)(size_t)a1);
    return __builtin_shufflevector(lo, hi, 0, 1, 2, 3, 4, 5, 6, 7);
}
__device__ __forceinline__ void p4_attn_mfma(const Ctx& F, const Args& a) {
    const bf16* P = (const bf16*)(a.ws + WS_REGA); const bf16* PC = P + (size_t)NTOK * MIXW; bf16* CAT = (bf16*)(a.ws + WS_CAT);
    LAS unsigned char* Kl = F.lds; LAS unsigned char* Vl = F.lds + 16384;
    const int w = F.wave, l = F.lane, qi = l & 31, h = l >> 5, tid = F.tid;
    constexpr float CS = 0.08838834764831845f * 1.4426950408889634f;
    unsigned ka[8];
#pragma unroll
    for (int ks = 0; ks < 8; ++ks) ka[ks] = offb(qi, 2 * ks + h);
    unsigned va[8];
    { const unsigned blk = (l >> 4) & 1, q4 = (l & 15) >> 2, p = l & 3;
#pragma unroll
      for (int c = 0; c < 4; ++c)
#pragma unroll
          for (int t = 0; t < 2; ++t) va[c * 2 + t] = (unsigned)(size_t)Vl + offb(8 * t + 4 * h + q4, 4 * c + 2 * blk + (p >> 1)) + 8 * (p & 1); }
    for (int u = F.vcu; u < 256; u += F.G) {
        const int kvh = u & 3, qb = (u >> 2) & 31, b = u >> 7;
        const int head = kvh * 2 + (w >> 2), q0 = qb * 128 + 32 * (w & 3);
        bf16x8_t Q[8];
        { const bf16* qrow = P + (size_t)(b * SEQ + q0 + qi) * MIXW + C_Q + head * 128 + 8 * h;
#pragma unroll
          for (int ks = 0; ks < 8; ++ks) Q[ks] = *(const GAS bf16x8_t*)(qrow + 16 * ks); }
        const float sink2 = a.in[9][head] * 1.4426950408889634f;
        float m = sink2, lsum = 1.f;
        f32x16 O[4];
#pragma unroll
        for (int c = 0; c < 4; ++c)
#pragma unroll
            for (int r = 0; r < 16; ++r) O[c][r] = 0.f;
        const int kt_lo = (2 * qb - 2 < 0) ? 0 : 2 * qb - 2, kt_hi = (2 * qb + 4 > 64) ? 64 : 2 * qb + 4, nlat = kt_hi - kt_lo, ntile = nlat + 4;
        v4u kr[2], vr[2];
        auto src_row = [&](int ti, int row) -> const bf16* { return (ti < nlat) ? (P + (size_t)(b * SEQ + (kt_lo + ti) * 64 + row) * MIXW) : (PC + (size_t)(b * CTXL + (ti - nlat) * 64 + row) * MIXW); };
#pragma unroll
        for (int i = 0; i < 2; ++i) { const int n = tid + 512 * i; const bf16* r0 = src_row(0, n >> 4) + kvh * 128 + 8 * (n & 15); kr[i] = *(const GAS v4u*)(r0 + C_K); vr[i] = *(const GAS v4u*)(r0 + C_V); }
        for (int ti = 0; ti < ntile; ++ti) {
            __syncthreads();
#pragma unroll
            for (int i = 0; i < 2; ++i) { const int n = tid + 512 * i; const unsigned o = offb(n >> 4, n & 15); *(LAS v4u*)(Kl + o) = kr[i]; *(LAS v4u*)(Vl + o) = vr[i]; }
            __syncthreads();
            if (ti + 1 < ntile) {
#pragma unroll
                for (int i = 0; i < 2; ++i) { const int n = tid + 512 * i; const bf16* r0 = src_row(ti + 1, n >> 4) + kvh * 128 + 8 * (n & 15); kr[i] = *(const GAS v4u*)(r0 + C_K); vr[i] = *(const GAS v4u*)(r0 + C_V); }
            }
            f32x16 S0, S1;
#pragma unroll
            for (int r = 0; r < 16; ++r) { S0[r] = 0.f; S1[r] = 0.f; }
#pragma unroll
            for (int ks = 0; ks < 8; ++ks) {
                const bf16x8_t a0 = *(const LAS bf16x8_t*)(Kl + ka[ks]), a1 = *(const LAS bf16x8_t*)(Kl + ka[ks] + 8192);
                S0 = __builtin_amdgcn_mfma_f32_32x32x16_bf16(a0, Q[ks], S0, 0, 0, 0);
                S1 = __builtin_amdgcn_mfma_f32_32x32x16_bf16(a1, Q[ks], S1, 0, 0, 0);
            }
            const bool lat = ti < nlat && (kt_lo + ti < 2 * qb || kt_lo + ti > 2 * qb + 1);     const int dbase = (q0 + qi) - ((kt_lo + ti) * 64 + 4 * h);
            float mx = -INFINITY;
#pragma unroll
            for (int r = 0; r < 16; ++r) {
                float t0 = S0[r] * CS, t1 = S1[r] * CS;
                if (lat) { const int d0 = dbase - ((r & 3) + 8 * (r >> 2)), d1 = d0 - 32; if ((unsigned)(d0 + 128) > 256u) t0 = -INFINITY; if ((unsigned)(d1 + 128) > 256u) t1 = -INFINITY; }
                S0[r] = t0; S1[r] = t1; mx = fmaxf(mx, fmaxf(t0, t1));
            }
            mx = fmaxf(mx, __shfl_xor(mx, 32));
            const float mn = fmaxf(m, mx), alpha = __builtin_amdgcn_exp2f(m - mn);
            float rs = 0.f;
#pragma unroll
            for (int r = 0; r < 16; ++r) { S0[r] = __builtin_amdgcn_exp2f(S0[r] - mn); S1[r] = __builtin_amdgcn_exp2f(S1[r] - mn); rs += S0[r] + S1[r]; }
            rs += __shfl_xor(rs, 32);
            lsum = lsum * alpha + rs; m = mn;
#pragma unroll
            for (int c = 0; c < 4; ++c)
#pragma unroll
                for (int r = 0; r < 16; ++r) O[c][r] *= alpha;
            bf16x8_t Pf[4];
#pragma unroll
            for (int s = 0; s < 2; ++s) {
                union { bf16x8_t v; unsigned u[4]; } x0, x1;
#pragma unroll
                for (int j = 0; j < 4; ++j) { x0.u[j] = cvtpk(S0[8 * s + 2 * j], S0[8 * s + 2 * j + 1]); x1.u[j] = cvtpk(S1[8 * s + 2 * j], S1[8 * s + 2 * j + 1]); }
                Pf[s] = x0.v; Pf[2 + s] = x1.v;
            }
#define ATT_PV(KK, OFF) do { \
                O[0] = __builtin_amdgcn_mfma_f32_32x32x16_bf16(trd2(va[0] + (OFF), va[1] + (OFF)), Pf[KK], O[0], 0, 0, 0); O[1] = __builtin_amdgcn_mfma_f32_32x32x16_bf16(trd2(va[2] + (OFF), va[3] + (OFF)), Pf[KK], O[1], 0, 0, 0); \
                O[2] = __builtin_amdgcn_mfma_f32_32x32x16_bf16(trd2(va[4] + (OFF), va[5] + (OFF)), Pf[KK], O[2], 0, 0, 0); O[3] = __builtin_amdgcn_mfma_f32_32x32x16_bf16(trd2(va[6] + (OFF), va[7] + (OFF)), Pf[KK], O[3], 0, 0, 0); } while (0)
            ATT_PV(0, 0); ATT_PV(1, 4096); ATT_PV(2, 8192); ATT_PV(3, 12288);
#undef ATT_PV
        }
        const float inv = 1.f / lsum;
        bf16* orow = CAT + (size_t)(b * SEQ + q0 + qi) * D + head * 128 + 4 * h;
#pragma unroll
        for (int c = 0; c < 4; ++c)
#pragma unroll
            for (int rr = 0; rr < 4; ++rr)
                *(GAS v2u*)(orow + 32 * c + 8 * rr) = (v2u){cvtpk(O[c][4 * rr] * inv, O[c][4 * rr + 1] * inv), cvtpk(O[c][4 * rr + 2] * inv, O[c][4 * rr + 3] * inv)};
    }
}
constexpr int HG_QP = 0, HG_KP = 16384, HG_VV = 32768, HG_SC = 49152, HG_EM = 58368, HG_EE = 58880, HG_T0 = 59392, HG_DIR = 61440;
constexpr size_t HG_LSZ = (size_t)128 * 128;
constexpr size_t WS_HGL = WS_X1, WS_HGG = WS_X1 + (size_t)2 * 16 * 17 * HG_LSZ * 4, WS_HGS = WS_YX;
static_assert(WS_HGG + (size_t)2 * 16 * 17 * 256 * 4 <= WS_X2 && (size_t)2 * 16 * 16 * HG_LSZ * 4 <= (size_t)NTOK * D * 4, "hgrn workspace");
#define TR2(d0, d1, a0, a1, OFF) asm volatile("ds_read_b64_tr_b16 %0, %2 offset:" #OFF "\n\tds_read_b64_tr_b16 %1, %3 offset:" #OFF "\n\ts_waitcnt lgkmcnt(0)" : "=&v"(d0), "=&v"(d1) : "v"(a0), "v"(a1) : "memory")

template <bool OUT> __device__ __forceinline__ void hg_unit(const Ctx& F, const Args& a, int b, int hh, int chunk  ) {
    const bf16* P = (const bf16*)(a.ws + WS_REGA); const float* sm = (const float*)(a.ws + WS_SMALL);
    const int dir = F.wave >> 2, wd = F.wave & 3, l = F.lane, qi = l & 31, h = l >> 5, tt = F.tid & 255, kch = tt & 127, half = tt >> 7;
    LAS unsigned char* Ld = F.lds + dir * HG_DIR;
    const GAS bf16* rows = (const GAS bf16*)((chunk < 16) ? (P + (size_t)(b * SEQ + chunk * 256) * MIXW) : (P + (size_t)(NTOK + b * CTXL) * MIXW));
    const int chain = b * 8 + hh;
    const float lbk = ((const GAS float*)sm)[SM_LB + dir * 1024 + hh * 128 + kch];
    f32x16 S[4];
    if (OUT) { const GAS float* s0 = (const GAS float*)(a.ws + WS_HGS) + ((size_t)(dir * 16 + chain) * 16 + chunk) * HG_LSZ + 32 * wd + qi;
#pragma unroll
        for (int kt = 0; kt < 4; ++kt)
#pragma unroll
            for (int r = 0; r < 16; ++r) S[kt][r] = s0[(size_t)(32 * kt + (r & 3) + 8 * (r >> 2) + 4 * h) * 128]; }
    else {
#pragma unroll
        for (int kt = 0; kt < 4; ++kt)
#pragma unroll
            for (int r = 0; r < 16; ++r) S[kt][r] = 0.f; }
    float gtot = 0.f;
    unsigned vta[2], kta[8];
    { const unsigned blk = (l >> 4) & 1, q4 = (l & 15) >> 2, p = l & 3;
#pragma unroll
      for (int t = 0; t < 2; ++t) { vta[t] = (unsigned)(size_t)(Ld + HG_VV) + offb(8 * h + 4 * t + q4, 4 * wd + 2 * blk + (p >> 1)) + 8 * (p & 1);
#pragma unroll
          for (int kt = 0; kt < 4; ++kt) kta[kt * 2 + t] = (unsigned)(size_t)(Ld + HG_KP) + offb(8 * h + 4 * t + q4, 4 * kt + 2 * blk + (p >> 1)) + 8 * (p & 1); } }
    v4u rk[4], rv[4], rq[4];
#pragma unroll
    for (int i = 0; i < 4; ++i) { const int n = tt + 256 * i, t = n >> 4, ch = n & 15, tok = dir ? 255 - t : t;
        const GAS bf16* rp = rows + (size_t)tok * MIXW + hh * 128 + 8 * ch;
        rk[i] = *(const GAS v4u*)(rp + (dir ? C_FB : C_FF)); rv[i] = *(const GAS v4u*)(rp + C_HI); if (OUT) rq[i] = *(const GAS v4u*)(rp + C_HQ); else rq[i] = rk[i]; }
#pragma unroll 1
    for (int sub = 0; sub < 4; ++sub) {
#pragma unroll
        for (int i = 0; i < 4; ++i) { const int n = tt + 256 * i, t = n >> 4, ch = n & 15; const unsigned o = offb(t, ch);
            *(LAS v4u*)(Ld + HG_KP + o) = rk[i]; *(LAS v4u*)(Ld + HG_VV + o) = rv[i]; if (OUT) *(LAS v4u*)(Ld + HG_QP + o) = rq[i]; }
        __syncthreads();
        if (sub < 3) {
#pragma unroll
            for (int i = 0; i < 4; ++i) { const int n = tt + 256 * i, t = n >> 4, ch = n & 15, p = 64 * (sub + 1) + t, tok = dir ? 255 - p : p;
                const GAS bf16* rp = rows + (size_t)tok * MIXW + hh * 128 + 8 * ch;
                rk[i] = *(const GAS v4u*)(rp + (dir ? C_FB : C_FF)); rv[i] = *(const GAS v4u*)(rp + C_HI); if (OUT) rq[i] = *(const GAS v4u*)(rp + C_HQ); }
        }
        { float prod = 1.f;
#pragma unroll 8
          for (int ii = 0; ii < 32; ++ii) { const int i = half ? ii : 31 - ii, t = 32 * half + i;
              const unsigned o = offb(t, kch >> 3) + 2 * (kch & 7);
              const float xl = bf2f(*(const LAS unsigned short*)(Ld + HG_KP + o)); const float f = lbk + (1.f - lbk) * fsigmoid(xl);
              float up, dn;
              if (half) { prod *= f; up = prod; dn = __builtin_amdgcn_rcpf(prod); } else { dn = prod; up = __builtin_amdgcn_rcpf(prod); prod *= f; }
              *(LAS unsigned short*)(Ld + HG_KP + o) = (unsigned short)f2bf((1.f - f) * dn);
              if (OUT) { const float q = bf2f(*(const LAS unsigned short*)(Ld + HG_QP + o)); *(LAS unsigned short*)(Ld + HG_QP + o) = (unsigned short)f2bf(q * up); } }
          *(LAS float*)(Ld + (half ? HG_EE : HG_EM) + 4 * kch) = prod; gtot += __logf(prod); }
        __syncthreads();
        if (OUT) {
            const int mt = wd >> 1, nt = wd & 1;
            f32x16 C;
#pragma unroll
            for (int r = 0; r < 16; ++r) C[r] = 0.f;
            if (!(mt == 0 && nt == 1)) {
#pragma unroll
                for (int ks = 0; ks < 8; ++ks) { const bf16x8_t af = *(const LAS bf16x8_t*)(Ld + HG_QP + offb(32 * mt + qi, 2 * ks + h)), bfv = *(const LAS bf16x8_t*)(Ld + HG_KP + offb(32 * nt + qi, 2 * ks + h));
                    C = __builtin_amdgcn_mfma_f32_32x32x16_bf16(af, bfv, C, 0, 0, 0); } }
            const int s = 32 * nt + qi;
#pragma unroll
            for (int r = 0; r < 16; ++r) { const int t = 32 * mt + (r & 3) + 8 * (r >> 2) + 4 * h; const float v = (s <= t) ? C[r] : 0.f;
                *(LAS unsigned short*)(Ld + HG_SC + t * 144 + 2 * s) = (unsigned short)f2bf(v); }
        }
#pragma unroll
        for (int kt = 0; kt < 4; ++kt)
#pragma unroll
            for (int rr = 0; rr < 4; ++rr) { const f32x4 e4 = *(const LAS f32x4*)(Ld + HG_EM + 4 * (32 * kt + 8 * rr + 4 * h));
#pragma unroll
                for (int j = 0; j < 4; ++j) S[kt][4 * rr + j] *= e4[j]; }
        if (OUT) __syncthreads();
        bf16x8_t Vf[4];
        Vf[0] = trd2(vta[0], vta[1]); Vf[1] = trd2(vta[0] + 4096, vta[1] + 4096); Vf[2] = trd2(vta[0] + 8192, vta[1] + 8192); Vf[3] = trd2(vta[0] + 12288, vta[1] + 12288);
        if (OUT) {
            f32x16 o0, o1;
#pragma unroll
            for (int r = 0; r < 16; ++r) { o0[r] = 0.f; o1[r] = 0.f; }
#pragma unroll
            for (int kt = 0; kt < 4; ++kt)
#pragma unroll
                for (int s2 = 0; s2 < 2; ++s2) {
                    union { bf16x8_t v; unsigned u[4]; } sb;
#pragma unroll
                    for (int j = 0; j < 4; ++j) sb.u[j] = cvtpk(S[kt][8 * s2 + 2 * j], S[kt][8 * s2 + 2 * j + 1]);
                    union { bf16x8_t v; v2u p[2]; } q0, q1;
                    q0.p[0] = *(const LAS v2u*)(Ld + HG_QP + offb(qi, 4 * kt + 2 * s2) + 8 * h); q0.p[1] = *(const LAS v2u*)(Ld + HG_QP + offb(qi, 4 * kt + 2 * s2 + 1) + 8 * h);
                    q1.p[0] = *(const LAS v2u*)(Ld + HG_QP + offb(32 + qi, 4 * kt + 2 * s2) + 8 * h); q1.p[1] = *(const LAS v2u*)(Ld + HG_QP + offb(32 + qi, 4 * kt + 2 * s2 + 1) + 8 * h);
                    o0 = __builtin_amdgcn_mfma_f32_32x32x16_bf16(q0.v, sb.v, o0, 0, 0, 0); o1 = __builtin_amdgcn_mfma_f32_32x32x16_bf16(q1.v, sb.v, o1, 0, 0, 0);
                }
#pragma unroll
            for (int ss = 0; ss < 4; ++ss) { const bf16x8_t a0 = *(const LAS bf16x8_t*)(Ld + HG_SC + qi * 144 + 32 * ss + 16 * h), a1 = *(const LAS bf16x8_t*)(Ld + HG_SC + (32 + qi) * 144 + 32 * ss + 16 * h);
                o0 = __builtin_amdgcn_mfma_f32_32x32x16_bf16(a0, Vf[ss], o0, 0, 0, 0); o1 = __builtin_amdgcn_mfma_f32_32x32x16_bf16(a1, Vf[ss], o1, 0, 0, 0); }
            GAS float* O = (GAS float*)(a.ws + WS_REGB) + (size_t)dir * NTOK * 1024 + (size_t)(b * SEQ + chunk * 256) * 1024 + hh * 128 + 32 * wd + qi;
#pragma unroll
            for (int r = 0; r < 16; ++r) { const int t = (r & 3) + 8 * (r >> 2) + 4 * h, p0 = 64 * sub + t, p1 = p0 + 32;
                O[(size_t)(dir ? 255 - p0 : p0) * 1024] = o0[r]; O[(size_t)(dir ? 255 - p1 : p1) * 1024] = o1[r]; }
        }
#define HG_UPD(SS, OFF) do { _Pragma("unroll") for (int kt = 0; kt < 4; ++kt) \
            S[kt] = __builtin_amdgcn_mfma_f32_32x32x16_bf16(trd2(kta[kt * 2] + (OFF), kta[kt * 2 + 1] + (OFF)), Vf[SS], S[kt], 0, 0, 0); } while (0)
        HG_UPD(0, 0); HG_UPD(1, 4096); HG_UPD(2, 8192); HG_UPD(3, 12288);
#undef HG_UPD
#pragma unroll
        for (int kt = 0; kt < 4; ++kt)
#pragma unroll
            for (int rr = 0; rr < 4; ++rr) { const f32x4 e4 = *(const LAS f32x4*)(Ld + HG_EE + 4 * (32 * kt + 8 * rr + 4 * h));
#pragma unroll
                for (int j = 0; j < 4; ++j) S[kt][4 * rr + j] *= e4[j]; }
        __syncthreads();
    }
    if (!OUT) {
        GAS float* Lp = (GAS float*)(a.ws + WS_HGL) + ((size_t)(dir * 16 + chain) * 17 + chunk) * HG_LSZ + 32 * wd + qi;
#pragma unroll
        for (int kt = 0; kt < 4; ++kt)
#pragma unroll
            for (int r = 0; r < 16; ++r) Lp[(size_t)(32 * kt + (r & 3) + 8 * (r >> 2) + 4 * h) * 128] = S[kt][r];
        ((float*)(a.ws + WS_HGG))[(((size_t)(dir * 16 + chain) * 17 + chunk) * 2 + half) * 128 + kch] = gtot;
    }
}
__device__ __forceinline__ void p_hg_summaries(const Ctx& F, const Args& a) {
    for (int u = F.vcu; u < 256; u += F.G) hg_unit<false>(F, a, (u >> 4) >> 3, (u >> 4) & 7, u & 15);
}
__device__ __forceinline__ void p_hg_ctx_summaries(const Ctx& F, const Args& a, int first, int nblk) {
    for (int u = F.vcu - first; u >= 0 && u < 16; u += nblk) hg_unit<false>(F, a, u >> 3, u & 7, 16);
}
__device__ __forceinline__ void p_hg_carry(const Ctx& F, const Args& a) {
    const float* Lb = (const float*)(a.ws + WS_HGL); const float* Gb = (const float*)(a.ws + WS_HGG); float* Sb = (float*)(a.ws + WS_HGS);
    for (int i = F.vcu * NTHR + F.tid; i < 32 * 4096; i += F.G * NTHR) {
        const int dc = i >> 12, e4 = (i & 4095) * 4, k = e4 >> 7, dir = dc >> 4;
        const float* Lc = Lb + (size_t)dc * 17 * HG_LSZ + e4; const float* Gc = Gb + (size_t)dc * 17 * 256 + k; float* Sc = Sb + (size_t)dc * 16 * HG_LSZ + e4;
        f32x4 s = *(const GAS f32x4*)(Lc + 16 * HG_LSZ);
#pragma unroll
        for (int j = 0; j < 16; ++j) { const int c = dir ? 15 - j : j;
            *(GAS f32x4*)(Sc + (size_t)c * HG_LSZ) = s;
            s = s * __expf(Gc[c * 256] + Gc[c * 256 + 128]) + *(const GAS f32x4*)(Lc + (size_t)c * HG_LSZ); }
    }
}
__device__ __forceinline__ void hg_norm_unit(const Ctx& F, const Args& a, int b, int hh, int chunk) {
    const bf16* P = (const bf16*)(a.ws + WS_REGA); bf16* CAT = (bf16*)(a.ws + WS_CAT); const float* gain = a.in[11];
    const __amdgpu_buffer_rsrc_t ors = __builtin_amdgcn_make_buffer_rsrc((void*)(a.ws + WS_REGB), 0, 0x7fffffff, 0x00020000);
    int tz = threadIdx.x; asm volatile("" : "+v"(tz));
    const int lane = tz & 63, wv = __builtin_amdgcn_readfirstlane(tz >> 6); const f32x2v gn = *(const GAS f32x2v*)(gain + hh * 128 + 2 * lane);
    for (int r0 = wv * 8; r0 < 256; r0 += NWAVES * 8) {
        float a0[8], a1[8]; unsigned gw[8];
#pragma unroll
        for (int u = 0; u < 8; ++u) { const int t = b * SEQ + chunk * 256 + r0 + u; const unsigned off = (unsigned)(((size_t)t * 1024 + hh * 128 + 2 * lane) * 4);
            const f32x2v f = __builtin_bit_cast(f32x2v, __builtin_amdgcn_raw_buffer_load_b64(ors, (int)off, 0, 0)), bq = __builtin_bit_cast(f32x2v, __builtin_amdgcn_raw_buffer_load_b64(ors, (int)(off + (unsigned)NTOK * 1024u * 4u), 0, 0));
            a0[u] = f[0] + bq[0]; a1[u] = f[1] + bq[1];
            gw[u] = *(const GAS unsigned*)(P + (size_t)t * MIXW + C_HG + hh * 128 + 2 * lane); }
#pragma unroll
        for (int u = 0; u < 8; ++u) { const int t = b * SEQ + chunk * 256 + r0 + u;
            const float r = rsqrtf(wave_sum(a0[u] * a0[u] + a1[u] * a1[u]) * (1.f / 128.f) + NORM_EPS);
            *(GAS unsigned*)(CAT + (size_t)t * D + 1024 + hh * 128 + 2 * lane) = pk2(a0[u] * r * gn[0] * bflo(gw[u]), a1[u] * r * gn[1] * bfhi(gw[u]));   }
    }
}
__device__ __forceinline__ void p_hg_outputs(const Ctx& F, const Args& a) {
    for (int u = F.vcu; u < 256; u += F.G) { const int b = (u >> 4) >> 3, hh = (u >> 4) & 7, chunk = u & 15;
        hg_unit<true>(F, a, b, hh, chunk);
        asm volatile("s_waitcnt vmcnt(0)" ::: "memory"); __syncthreads();
        hg_norm_unit(F, a, b, hh, chunk); }
}
typedef _Float16 f16x8 __attribute__((ext_vector_type(8)));
typedef _Float16 f16x4 __attribute__((ext_vector_type(4)));
__device__ __forceinline__ void route_row(const LAS float* lgv, const float* brg, const float* bre, LAS unsigned* cnt, int* smi, int row) {
    float gl[4]; int gi = 0;
#pragma unroll
    for (int i = 0; i < 4; ++i) gl[i] = lgv[32 + i] + brg[i];
    float gm = gl[0];
#pragma unroll
    for (int i = 1; i < 4; ++i) if (gl[i] > gm) { gm = gl[i]; gi = i; }
    float gz = 0.f;
#pragma unroll
    for (int i = 0; i < 4; ++i) gz += expf(gl[i] - gm);
    const float gval = 1.f / gz;
    float el[8];
#pragma unroll
    for (int j = 0; j < 8; ++j) el[j] = lgv[gi * 8 + j] + bre[gi * 8 + j];
    int i1 = 0; float m1 = el[0];
#pragma unroll
    for (int j = 1; j < 8; ++j) if (el[j] > m1) { m1 = el[j]; i1 = j; }
    int i2 = 0; float m2 = -INFINITY;
#pragma unroll
    for (int j = 0; j < 8; ++j) if (j != i1 && el[j] > m2) { m2 = el[j]; i2 = j; }
    const float p2 = expf(m2 - m1), ga = gval / (1.f + p2), gb = gval * p2 / (1.f + p2);
    const int e1 = gi * 8 + i1, e2 = gi * 8 + i2;
    const int r1 = (int)__hip_atomic_fetch_add(cnt + e1, 1u, __ATOMIC_RELAXED, __HIP_MEMORY_SCOPE_WORKGROUP), r2 = (int)__hip_atomic_fetch_add(cnt + e2, 1u, __ATOMIC_RELAXED, __HIP_MEMORY_SCOPE_WORKGROUP);
    smi[SM_TOKE + 2 * row] = e1; smi[SM_TOKE + 2 * row + 1] = e2; smi[SM_TOKR + 2 * row] = r1; smi[SM_TOKR + 2 * row + 1] = r2;
    ((float*)smi)[SM_TOKG + 2 * row] = ga; ((float*)smi)[SM_TOKG + 2 * row + 1] = gb;
}
template <bool XB>
__device__ __forceinline__ void p_ln_router(const Ctx& F, const Args& a, int layer, const void* xres_, const bf16* Y, bf16* X1, bf16* TOK) {
    const float* xres = (const float*)xres_; const bf16* xrb = (const bf16*)xres_;
    const float* sm = (const float*)(a.ws + WS_SMALL); int* smi = (int*)(a.ws + WS_SMALL);
    const float* lg = a.in[6] + (layer * 2 + 0) * D; const float* lbias = a.in[7] + (layer * 2 + 0) * D;
    const float* brg = a.in[18] + layer * 4; const float* bre = a.in[20] + layer * 32;
    const GAS f16x8* wfr = (const GAS f16x8*)(a.ws + WS_W16) + (size_t)layer * 128 * 2 * 64;
    const int w = F.wave, l = F.lane;
    LAS unsigned char* timg = F.lds;
    LAS float* part = (LAS float*)F.lds;
    LAS float* lgt = (LAS float*)(F.lds + 40960);
    LAS unsigned* lcnt = (LAS unsigned*)(F.lds + 152064);
    if (F.tid < 32) lcnt[F.tid] = 0u;
    for (int grp = F.vcu; grp < NTOK / 32; grp += F.G) {
        __syncthreads();
#pragma unroll 1
        for (int r4 = 0; r4 < 4; ++r4) {
            const int rl = 4 * w + r4, row = grp * 32 + rl, b = row / SEQ; const float* mod = sm + SM_MOD + (layer * 2 + b) * 6 * D;
            f32x4 v[8]; float s = 0.f;
#pragma unroll
            for (int j = 0; j < 8; ++j) { const int d = 4 * l + 256 * j; f32x4 xv; if constexpr (XB) { const v2u xw = *(const GAS v2u*)(xrb + (size_t)row * D + d); xv = (f32x4){bflo(xw.x), bfhi(xw.x), bflo(xw.y), bfhi(xw.y)}; } else xv = *(const GAS f32x4*)(xres + (size_t)row * D + d);
                const f32x4 gv = *(const GAS f32x4*)(mod + 2 * D + d); const v2u yw = *(const GAS v2u*)(Y + (size_t)row * D + d);
                const f32x4 yv = (f32x4){bflo(yw.x), bfhi(yw.x), bflo(yw.y), bfhi(yw.y)};
                v[j] = xv * ALPHA + gv * yv; s += (v[j][0] + v[j][1]) + (v[j][2] + v[j][3]); }
            const float mean = wave_sum(s) * (1.f / D); float q = 0.f;
#pragma unroll
            for (int j = 0; j < 8; ++j) { v[j] = v[j] - mean; q += (v[j][0] * v[j][0] + v[j][1] * v[j][1]) + (v[j][2] * v[j][2] + v[j][3] * v[j][3]); }
            const float rstd = rsqrtf(wave_sum(q) * (1.f / D) + LN_EPS);
#pragma unroll
            for (int j = 0; j < 8; ++j) { const int d = 4 * l + 256 * j; const f32x4 o = v[j] * rstd * *(const GAS f32x4*)(lg + d) + *(const GAS f32x4*)(lbias + d);
                *(GAS v2u*)(X1 + (size_t)row * D + d) = (v2u){pk2(o[0], o[1]), pk2(o[2], o[3])};
                const f32x4 t4 = o * (*(const GAS f32x4*)(mod + 4 * D + d) + 1.f) + *(const GAS f32x4*)(mod + 3 * D + d);
                *(GAS v2u*)(TOK + (size_t)row * D + d) = (v2u){pk2(t4[0], t4[1]), pk2(t4[2], t4[3])};
                *(LAS f16x4*)(timg + rl * 4096 + 16 * ((d >> 3) ^ (rl & 15)) + 2 * (d & 7)) = (f16x4){(_Float16)t4[0], (_Float16)t4[1], (_Float16)t4[2], (_Float16)t4[3]}; }
        }
        __syncthreads();
        f32x16 c0, c1;
#pragma unroll
        for (int r = 0; r < 16; ++r) { c0[r] = 0.f; c1[r] = 0.f; }
        { const int ar = l & 31, ah = l >> 5;
#pragma unroll 4
          for (int ks = 0; ks < 16; ++ks) { const int ksg = 16 * w + ks;
              const f16x8 af = *(const LAS f16x8*)(timg + ar * 4096 + 16 * ((2 * ksg + ah) ^ (ar & 15)));
              const f16x8 b0 = wfr[(size_t)(ksg * 2 + 0) * 64 + l], b1 = wfr[(size_t)(ksg * 2 + 1) * 64 + l];
              c0 = __builtin_amdgcn_mfma_f32_32x32x16_f16(af, b0, c0, 0, 0, 0); c1 = __builtin_amdgcn_mfma_f32_32x32x16_f16(af, b1, c1, 0, 0, 0); } }
        __syncthreads();
        { const int col = l & 31, ah = l >> 5;
#pragma unroll
          for (int r = 0; r < 16; ++r) { const int row = (r & 3) + 8 * (r >> 2) + 4 * ah; part[(w * 32 + row) * 36 + col] = c0[r]; if (col < 4) part[(w * 32 + row) * 36 + 32 + col] = c1[r]; } }
        __syncthreads();
        for (int i = F.tid; i < 32 * 36; i += NTHR) { float sacc = 0.f;
#pragma unroll
            for (int ww = 0; ww < 8; ++ww) sacc += part[ww * 32 * 36 + i];
            lgt[i] = sacc; }
        __syncthreads();
        if (F.tid < 32) route_row(lgt + F.tid * 36, brg, bre, lcnt, smi, grp * 32 + F.tid);
    }
    __syncthreads();
    if (F.tid < 32) smi[SM_BCNT + (layer * 256 + F.vcu) * 32 + F.tid] = (int)lcnt[F.tid];
}
__device__ __forceinline__ void moe_table(const Ctx& F, const Args& a, int layer, bool bases) {
    const int* bc = (const int*)(a.ws + WS_SMALL) + SM_BCNT + layer * 256 * 32;
    LAS int* tab = (LAS int*)(F.lds + LDS_TAB); LAS int* part = (LAS int*)F.lds; LAS int* bb = part + 512;
    const int e = F.tid & 31, seg = F.tid >> 5;
    int sum = 0;
    for (int i = 0; i < 16; ++i) { const int wg = seg * 16 + i; if (wg < F.G) sum += bc[wg * 32 + e]; }
    part[seg * 32 + e] = sum;
    __syncthreads();
    int pre = 0, tot = 0;
    for (int s = 0; s < 16; ++s) { const int v = part[s * 32 + e]; if (s < seg) pre += v; tot += v; }
    if (seg == 0) tab[e] = (tot + 255) >> 8;
    if (bases) { int run = pre; for (int i = 0; i < 16; ++i) { const int wg = seg * 16 + i; if (wg < F.G) { bb[e * 256 + wg] = run; run += bc[wg * 32 + e]; } } }
    __syncthreads();
}
__device__ __forceinline__ void p_gather(const Ctx& F, const Args& a, int layer) {
    moe_table(F, a, layer, true);
    const LAS int* tab = (const LAS int*)(F.lds + LDS_TAB); const LAS int* bb = (const LAS int*)F.lds + 512; int* smi = (int*)(a.ws + WS_SMALL);
    for (int as = F.vcu * NTHR + F.tid; as < 2 * NTOK; as += F.G * NTHR) {
        const int e = smi[SM_TOKE + as], r = smi[SM_TOKR + as], wg = ((as >> 1) >> 5) % F.G; int pre = 0;
        for (int i = 0; i < e; ++i) pre += tab[i];
        const int slot = 256 * pre + bb[e * 256 + wg] + r;
        smi[SM_TOKS + as] = slot; smi[SM_SLOTTOK + slot] = as >> 1;
    }
}
template <bool OB>
__device__ __forceinline__ void p_ln2(const Ctx& F, const Args& a, int layer, void* XO_, bf16* HXN) {
    float* XO = (float*)XO_; bf16* XOB = (bf16*)XO_;
    const float* sm = (const float*)(a.ws + WS_SMALL); const int* smi = (const int*)(a.ws + WS_SMALL);
    const bf16* X1 = (const bf16*)(a.ws + WS_X1); const bf16* YS = (const bf16*)(a.ws + WS_REGB);
    const float* lg = a.in[6] + (layer * 2 + 1) * D; const float* lbias = a.in[7] + (layer * 2 + 1) * D;
    const int l = F.lane;
    for (int row0 = F.vcu * NWAVES + F.wave; row0 < NTOK; row0 += 2 * F.G * NWAVES) {
        f32x4 v[2][8]; float mean[2], rstd[2]; int rows[2]; bool ok[2];
#pragma unroll
        for (int u = 0; u < 2; ++u) { const int row = row0 + u * F.G * NWAVES; ok[u] = row < NTOK; rows[u] = ok[u] ? row : row0;
            const int r = rows[u], b = r / SEQ; const float* mod = sm + SM_MOD + (layer * 2 + b) * 6 * D;
            const int s0 = smi[SM_TOKS + 2 * r], s1 = smi[SM_TOKS + 2 * r + 1]; const float g0 = sm[SM_TOKG + 2 * r], g1 = sm[SM_TOKG + 2 * r + 1];
#pragma unroll
            for (int j = 0; j < 8; ++j) { const int d = 4 * l + 256 * j; const v2u xw = *(const GAS v2u*)(X1 + (size_t)r * D + d); const f32x4 xv = (f32x4){bflo(xw.x), bfhi(xw.x), bflo(xw.y), bfhi(xw.y)}, gv = *(const GAS f32x4*)(mod + 5 * D + d);
                const v2u y0 = *(const GAS v2u*)(YS + (size_t)s0 * D + d), y1 = *(const GAS v2u*)(YS + (size_t)s1 * D + d);
                const f32x4 yv = (f32x4){bflo(y0.x), bfhi(y0.x), bflo(y0.y), bfhi(y0.y)} * g0 + (f32x4){bflo(y1.x), bfhi(y1.x), bflo(y1.y), bfhi(y1.y)} * g1;
                v[u][j] = xv * ALPHA + gv * yv; } }
#pragma unroll
        for (int u = 0; u < 2; ++u) { float s = 0.f;
#pragma unroll
            for (int j = 0; j < 8; ++j) s += (v[u][j][0] + v[u][j][1]) + (v[u][j][2] + v[u][j][3]);
            mean[u] = wave_sum(s) * (1.f / D); float q = 0.f;
#pragma unroll
            for (int j = 0; j < 8; ++j) { v[u][j] = v[u][j] - mean[u]; q += (v[u][j][0] * v[u][j][0] + v[u][j][1] * v[u][j][1]) + (v[u][j][2] * v[u][j][2] + v[u][j][3] * v[u][j][3]); }
            rstd[u] = rsqrtf(wave_sum(q) * (1.f / D) + LN_EPS); }
#pragma unroll
        for (int j = 0; j < 8; ++j) { const int d = 4 * l + 256 * j; const f32x4 lgv = *(const GAS f32x4*)(lg + d), lbv = *(const GAS f32x4*)(lbias + d);
#pragma unroll
            for (int u = 0; u < 2; ++u) { if (!ok[u]) continue; const int row = rows[u], b = row / SEQ; const float* modn = sm + SM_MOD + ((layer + 1) * 2 + b) * 6 * D;
                const f32x4 o = v[u][j] * rstd[u] * lgv + lbv;
                if constexpr (OB) *(GAS v2u*)(XOB + (size_t)row * D + d) = (v2u){pk2(o[0], o[1]), pk2(o[2], o[3])}; else *(GAS f32x4*)(XO + (size_t)row * D + d) = o;
                if (HXN) { const f32x4 hx = o * (*(const GAS f32x4*)(modn + D + d) + 1.f) + *(const GAS f32x4*)(modn + d); *(GAS v2u*)(HXN + (size_t)row * D + d) = (v2u){pk2(hx[0], hx[1]), pk2(hx[2], hx[3])}; } } }
    }
}
template <int W> __device__ __forceinline__ void pool_item8(const bf16* U, bf16* MX, int t0, int d) {
    const int b = t0 / SEQ, n0 = t0 % SEQ, lo0 = n0 - W / 2;
    v4u x[W + 7];
#pragma unroll
    for (int j = 0; j < W + 7; ++j) { const int p = lo0 + j, pc = p < 0 ? 0 : (p >= SEQ ? SEQ - 1 : p); x[j] = *(const GAS v4u*)(U + (size_t)(b * SEQ + pc) * D + d); }
#pragma unroll
    for (int q = 0; q < 8; ++q) {
        float acc[8] = {0.f, 0.f, 0.f, 0.f, 0.f, 0.f, 0.f, 0.f}; int cnt = 0;
#pragma unroll
        for (int j = 0; j < W; ++j) { const int p = lo0 + q + j; const bool ok = (p >= 0) && (p < SEQ); cnt += ok ? 1 : 0; const v4u v = x[q + j];
            if (ok) { acc[0] += bflo(v.x); acc[1] += bfhi(v.x); acc[2] += bflo(v.y); acc[3] += bfhi(v.y); acc[4] += bflo(v.z); acc[5] += bfhi(v.z); acc[6] += bflo(v.w); acc[7] += bfhi(v.w); } }
        const v4u sv = x[q + W / 2]; const float inv = 1.f / (float)cnt;
        *(GAS v4u*)(MX + (size_t)(t0 + q) * D + d) = (v4u){pk2(acc[0] * inv - bflo(sv.x), acc[1] * inv - bfhi(sv.x)), pk2(acc[2] * inv - bflo(sv.y), acc[3] * inv - bfhi(sv.y)),
                                                      pk2(acc[4] * inv - bflo(sv.z), acc[5] * inv - bfhi(sv.z)), pk2(acc[6] * inv - bflo(sv.w), acc[7] * inv - bfhi(sv.w))};
    }
}
__device__ __forceinline__ void p_pool(const Ctx& F, const Args& a) {
    const bf16* U = (const bf16*)(a.ws + WS_REGA); bf16* MX = (bf16*)(a.ws + WS_REGA) + (size_t)NTOK * D;
    for (int i = F.vcu * NTHR + F.tid; i < (NTOK / 8) * (D / 8); i += F.G * NTHR) {
        const int t0 = (i >> 8) * 8, d = (i & 255) * 8, g = d >> 9;
        if (g == 0) pool_item8<2>(U, MX, t0, d); else if (g == 1) pool_item8<4>(U, MX, t0, d); else if (g == 2) pool_item8<8>(U, MX, t0, d); else pool_item8<16>(U, MX, t0, d);
    }
}
#ifndef MK_PER_PHASE
#define MK_PER_PHASE 0
#endif
constexpr int NPHASE = 20;
__global__ void __launch_bounds__(NTHR, 2) fwd(Args args) {
    extern __shared__ __attribute__((aligned(16))) unsigned char lds_raw[];
    Ctx F; F.lds = (LAS unsigned char*)lds_raw; F.tid = threadIdx.x; F.lane = F.tid & 63; F.wave = __builtin_amdgcn_readfirstlane(F.tid >> 6);
    F.G = gridDim.x; { const int bx = blockIdx.x; F.vcu = (F.G % 8 == 0) ? (bx % 8) * (F.G / 8) + bx / 8 : bx; }
    unsigned char* ws = args.ws;
    for (int u = F.tid; u < (LDS_BYTES - LDS_CTLB) / 4; u += NTHR) ((LAS unsigned*)(F.lds + LDS_CTLB))[u] = 0u;
    __syncthreads();
    XcdBarrier bar = xcd_barrier_post((unsigned*)(ws + WS_CTL) + CW_BAR + (MK_PER_PHASE ? args.ph_lo : 0) * XCD_BAR_WORDS, (volatile LAS unsigned*)(F.lds + LDS_MISC) + 8);
    const int lo = args.ph_lo, hi = args.ph_hi;
#define IN(k) (lo <= (k) && (k) < hi)
#define REFRESH_CTX() do { int tz_ = threadIdx.x; asm volatile("" : "+v"(tz_)); F.tid = tz_; F.lane = tz_ & 63; F.wave = __builtin_amdgcn_readfirstlane(tz_ >> 6); } while (0)
#define SEAM(k) do { if (IN(k) && IN((k) + 1)) xcd_barrier(bar); } while (0)
    LAS unsigned char* ring = F.lds;
    const int cid = (int)blockIdx.x;
    bf16* HX = (bf16*)(ws + WS_HX); bf16* P16 = (bf16*)(ws + WS_REGA); bf16* CAT = (bf16*)(ws + WS_CAT); bf16* YXb = (bf16*)(ws + WS_YX);
    bf16* X1 = (bf16*)(ws + WS_X1); bf16* X2 = (bf16*)(ws + WS_X2); bf16* TOK = (bf16*)(ws + WS_TOK);
    bf16* XE = (bf16*)(ws + WS_REGA); bf16* Hb = (bf16*)(ws + WS_H); bf16* YS = (bf16*)(ws + WS_REGB);
    bf16* Ub = (bf16*)(ws + WS_REGA); bf16* MXb = Ub + (size_t)NTOK * D; bf16* YGb = MXb + (size_t)NTOK * D;

    if (IN(0)) { REFRESH_CTX(); p0_mod(F, args, 0, 192, F.vcu, F.G, true); p0_router_frags(F, args); p0_convert(F, args, F.vcu, F.G, false, 192); } SEAM(0);
    if (IN(1)) { REFRESH_CTX(); p1_modulate(F, args); } SEAM(1);
    if (IN(2)) { REFRESH_CTX(); {
        constexpr int NWG = pg8::InprojOrder::NWG; const int nfull = NWG / F.G, nbusy = NWG - nfull * F.G, nfree = F.G - nbusy; const bool tail = nfull > 0 && nbusy > 0 && nfree >= 32;
        unsigned* arrive = (unsigned*)(ws + WS_CTL) + CW_INARR;
        pg8::Gemm g{HX, (const bf16*)(ws + WS_WIN), D, D, D}; pg8::InprojOrder S; S.init(F.G, cid, D, D, tail ? arrive : nullptr);
        pg8::EpiBf16 E{P16, MIXW, nullptr, MIXW / 256, C_HQ / 256, C_FF / 256, C_HG / 256, MIXW / 256, C_V / 256, NTOK};
        pg8::gemm_phase<pg8::EpiBf16, pg8::InprojOrder, true, true>(ring, g, S, E);
        if (tail) { const int me = cid - nbusy;
            if (me >= 0 && me < 16) {
                if (threadIdx.x == 0) { unsigned* bw = bar.bar; XB_SPIN(xb_ld(arrive) < (unsigned)pg8::InprojOrder::NCTXU, bw); __builtin_amdgcn_fence(__ATOMIC_ACQUIRE, "agent"); asm volatile("s_waitcnt vmcnt(0)" ::: "memory"); }
                __syncthreads();
                hg_unit<false>(F, args, me >> 3, me & 7, 16);
                __syncthreads();
            }
            p0_mod(F, args, 192, 384, me, nfree, false, (unsigned*)(ws + WS_CTL) + CW_GVQ);
            __syncthreads(); p0_convert(F, args, me, nfree, false, -1);
        } else { p0_mod(F, args, 192, 384, nbusy > 0 ? cid - nbusy : F.vcu, nbusy > 0 ? nfree : F.G, false); __syncthreads(); p0_convert(F, args, F.vcu, F.G, false, -1); xcd_barrier(bar); p_hg_ctx_summaries(F, args, 0, F.G); } } }
    do { if (IN(2) && IN(4)) xcd_barrier(bar); } while (0);
    if (IN(4)) { REFRESH_CTX();
        p4_attn_mfma(F, args); p_hg_summaries(F, args);
    } SEAM(4);
    if (IN(5)) { REFRESH_CTX();
        p_hg_carry(F, args);
    } SEAM(5);
    if (IN(6)) { REFRESH_CTX();
        p_hg_outputs(F, args);
    } SEAM(6);
    if (IN(7)) { REFRESH_CTX(); { pg8::Gemm g{CAT, (const bf16*)(ws + WS_WOUT), D, D, D}; pg8::StaticOrder S; S.init(NTOK, D, F.G, cid, D, D); pg8::EpiBf16 E{YXb, D, nullptr, 8}; pg8::gemm_phase<pg8::EpiBf16, pg8::StaticOrder, true, true>(ring, g, S, E); } } SEAM(7);
    if (IN(8)) { REFRESH_CTX(); p_ln_router<false>(F, args, 0, args.in[0], YXb, X1, TOK); } SEAM(8);
    if (IN(9)) { REFRESH_CTX(); const bool has_slots = F.vcu * NTHR < 2 * NTOK;
        if (has_slots) p_gather(F, args, 0);
        {
          __syncthreads(); const bool sw = (F.G % 8 == 0) && F.G >= 16; const int xi = cid & 7, fold = sw ? (xi ? (cid >> 3) * 7 + xi - 1 : -1) : cid, fstride = sw ? (F.G / 8) * 7 : F.G;
          pg8::Gemm g{(const bf16*)(ws + WS_WPOUT), (const bf16*)(ws + WS_WGRP), 512, D, 512}; pg8::FoldOrder S{fold, fstride, D, 512}; pg8::EpiBf16 E{(bf16*)(ws + WS_WFOLD), D, nullptr, 8};
          pg8::gemm_phase<pg8::EpiBf16, pg8::FoldOrder, true, true>(ring, g, S, E);
          if (sw && fstride >= 128) p0_convert(F, args, fold - 64, fstride - 64, true); else p0_convert(F, args, F.vcu, F.G, true); }
        if (!has_slots) { __syncthreads(); moe_table(F, args, 0, false); } } SEAM(9);
    if (IN(10)) { REFRESH_CTX(); { if (MK_PER_PHASE) moe_table(F, args, 0, false);     pg8::FusedOrder S; S.init((const LAS int*)(F.lds + LDS_TAB), F.G, F.vcu); pg8::MoeCfg c0{TOK, D, (const int*)(ws + WS_SMALL) + SM_SLOTTOK, D, args.in[21] + (size_t)0 * NEXP * D * FF, args.in[22] + (size_t)0 * NEXP * D * FF, FF, (size_t)D * FF, 128, 4}; pg8::MoeCfg c1{Hb, FF, nullptr, FF, args.in[23] + (size_t)0 * NEXP * FF * D, args.in[23] + (size_t)0 * NEXP * FF * D + 128, D, (size_t)FF * D, 256, 8}; pg8::EpiSwiglu EA{Hb}; pg8::EpiBf16 EB{YS, D, nullptr, 8}; pg8::gemm_moe_fused<pg8::EpiSwiglu, pg8::EpiBf16>(ring, c0, c1, (unsigned*)(ws + WS_CTL) + CW_MCNT + 0 * 128, ws + WS_XBUF, (unsigned*)(ws + WS_CTL) + CW_XCNT + 0 * 512, S, EA, EB); } } SEAM(10);
    if (IN(11)) { REFRESH_CTX(); p_ln2<true>(F, args, 0, X2, HX); } SEAM(11);
    if (IN(12)) { REFRESH_CTX(); { pg8::Gemm g{HX, (const bf16*)(ws + WS_WPIN), D, D, D}; pg8::StaticOrder S; S.init(NTOK, D, F.G, cid, D, D);
        if (F.G == (NTOK / 256) * (D / 256)) {
            pg8::EpiPool E{MXb, ws + WS_HALO, (unsigned*)(ws + WS_CTL) + CW_HCNT, D, SEQ / 256}; pg8::gemm_phase<pg8::EpiPool, pg8::StaticOrder, true, true>(ring, g, S, E);
        } else { pg8::EpiBf16 E{Ub, D, nullptr, 8}; pg8::gemm_phase<pg8::EpiBf16, pg8::StaticOrder, true, true>(ring, g, S, E); } } }
    if (IN(12) && IN(13) && F.G != (NTOK / 256) * (D / 256)) xcd_barrier(bar);
    if (IN(13)) { REFRESH_CTX(); if (F.G != (NTOK / 256) * (D / 256)) p_pool(F, args); } do { if (IN(13) && IN(15)) xcd_barrier(bar); } while (0);
    if (IN(15)) { REFRESH_CTX(); { pg8::Gemm g{MXb, (const bf16*)(ws + WS_WFOLD), D, D, D}; pg8::StaticOrder S; S.init(NTOK, D, F.G, cid, D, D); pg8::EpiBf16 E{YXb, D, nullptr, 8}; pg8::gemm_phase<pg8::EpiBf16, pg8::StaticOrder, true, true>(ring, g, S, E); } } SEAM(15);
    if (IN(16)) { REFRESH_CTX(); p_ln_router<true>(F, args, 1, X2, YXb, X1, TOK); } SEAM(16);
    if (IN(17)) { REFRESH_CTX(); p_gather(F, args, 1); } SEAM(17);
    if (IN(18)) { REFRESH_CTX(); { if (MK_PER_PHASE) moe_table(F, args, 1, false);     pg8::FusedOrder S; S.init((const LAS int*)(F.lds + LDS_TAB), F.G, F.vcu); pg8::MoeCfg c0{TOK, D, (const int*)(ws + WS_SMALL) + SM_SLOTTOK, D, args.in[21] + (size_t)1 * NEXP * D * FF, args.in[22] + (size_t)1 * NEXP * D * FF, FF, (size_t)D * FF, 128, 4}; pg8::MoeCfg c1{Hb, FF, nullptr, FF, args.in[23] + (size_t)1 * NEXP * FF * D, args.in[23] + (size_t)1 * NEXP * FF * D + 128, D, (size_t)FF * D, 256, 8}; pg8::EpiSwiglu EA{Hb}; pg8::EpiBf16 EB{YS, D, nullptr, 8}; pg8::gemm_moe_fused<pg8::EpiSwiglu, pg8::EpiBf16>(ring, c0, c1, (unsigned*)(ws + WS_CTL) + CW_MCNT + 1 * 128, ws + WS_XBUF, (unsigned*)(ws + WS_CTL) + CW_XCNT + 1 * 512, S, EA, EB); } } SEAM(18);
    if (IN(19)) { REFRESH_CTX(); p_ln2<false>(F, args, 1, args.out, nullptr); }
#undef IN
#undef SEAM
}

extern "C" void kernel_launch(void* const* d_in, const int* in_sizes, int n_in, void* d_out, int out_size, void* d_ws, size_t ws_size, hipStream_t stream) {
    static int grid = 0;
    if (grid == 0) {
        if (n_in != 24 || ws_size < WS_END) { fprintf(stderr, "kernel_launch: need 24 inputs and >= %zu bytes of workspace (got %d, %zu)\n", (size_t)WS_END, n_in, ws_size); grid = -1; return; }
        int dev = 0, cus = 0;
        if (hipGetDevice(&dev) != hipSuccess || hipDeviceGetAttribute(&cus, hipDeviceAttributeMultiprocessorCount, dev) != hipSuccess) { grid = -1; return; }
        if (hipFuncSetAttribute((const void*)fwd, hipFuncAttributeMaxDynamicSharedMemorySize, LDS_BYTES) != hipSuccess) { fprintf(stderr, "kernel_launch: hipFuncSetAttribute failed\n"); grid = -1; return; }
        int per_cu = 0;
        if (hipOccupancyMaxActiveBlocksPerMultiprocessor(&per_cu, (const void*)fwd, NTHR, LDS_BYTES) != hipSuccess || per_cu < 1) { fprintf(stderr, "kernel_launch: occupancy query says %d blocks per CU\n", per_cu); }
        (void)hipGetLastError();
        grid = cus;
    }
    if (grid < 0) return;
    if (hipMemsetAsync((char*)d_ws + WS_CTL, 0, CTL_ZERO_BYTES, stream) != hipSuccess) return;
    Args a{};
    for (int i = 0; i < 24; ++i) a.in[i] = (const float*)d_in[i];
    a.out = (float*)d_out; a.ws = (unsigned char*)d_ws;
#if MK_PER_PHASE
    for (int p = 0; p < NPHASE; ++p) { a.ph_lo = p; a.ph_hi = p + 1; hipLaunchKernelGGL(fwd, dim3(grid), dim3(NTHR), LDS_BYTES, stream, a); }
#else
    a.ph_lo = 0; a.ph_hi = NPHASE;
    hipLaunchKernelGGL(fwd, dim3(grid), dim3(NTHR), LDS_BYTES, stream, a);
#endif
    const hipError_t le = hipPeekAtLastError();
    if (le != hipSuccess) fprintf(stderr, "kernel_launch: launch failed: %s\n", hipGetErrorName(le));
}
```

```cpp
#include <hip/hip_runtime.h>
#include <cstdio>
#include <cstdint>

namespace pg8 {
#define PG8_LAS __attribute__((address_space(3)))
typedef unsigned short bf16_t;
typedef short bf16x8 __attribute__((ext_vector_type(8)));
typedef float f32x4 __attribute__((ext_vector_type(4)));
typedef unsigned u32x4 __attribute__((ext_vector_type(4)));
constexpr int BM = 256, BK = 64, HALF = 128, HTB = HALF * BK * 2  , STAGE_BYTES = 8 * HTB, NXCD = 8, WGM = 8;

__host__ __device__ __forceinline__ int lds_byte(int r, int c) { const int st = (r >> 4) * 2 + (c >> 5), rr = r & 15, cc = c & 31, ob = rr * 64 + cc * 2; return st * 1024 + (ob ^ (((ob >> 9) & 1) << 5)); }
__host__ __device__ __forceinline__ void stage_rc(int b, int& R, int& C) { const int st = b / 1024, sb = b % 1024, swz = sb ^ (((sb >> 9) & 1) << 5); R = (st >> 1) * 16 + swz / 64; C = (st & 1) * 32 + (swz % 64) / 2; }
__host__ __device__ __forceinline__ int perm32(int rho) { const int n = rho >> 4, i = rho & 15; return 8 * (i >> 2) + 4 * n + (i & 3); }

struct Unit { int pm, pn; };
struct Gemm { const bf16_t* A; const bf16_t* Bt; int K, lda, ldb; };
__device__ __forceinline__ unsigned cvt_pk_bf16(float lo, float hi) { unsigned r; asm volatile("v_cvt_pk_bf16_f32 %0, %1, %2" : "=v"(r) : "v"(lo), "v"(hi)); return r; }
template <class Epi, class Sched, bool ALIGN_EPI = false, bool SP2 = false>
__device__ __forceinline__ void gemm_phase(PG8_LAS unsigned char* lds, const Gemm g, const Sched& S, const Epi& E) {
    const int tid = threadIdx.x, wid = __builtin_amdgcn_readfirstlane(tid >> 6), lane = tid & 63, wr = wid >> 2, wc = wid & 3, fr = lane & 15, fq = lane >> 4;
    const int K = g.K, nt = K / BK;
    unsigned voffA[2], voffB[2];
#pragma unroll
    for (int i = 0; i < 2; ++i) { int R, C; stage_rc(tid * 16 + i * 8192, R, C); const int Rb = Epi::PERM ? ((R & ~31) + perm32(R & 31)) : R;
        voffA[i] = (unsigned)(R * g.lda + C) * 2u; voffB[i] = (unsigned)(Rb * g.ldb + C) * 2u; }
    const size_t kstep = (size_t)(BK * 2);
    const size_t hsA = (size_t)HALF * g.lda * 2, hsB = (size_t)HALF * g.ldb * 2;
    const unsigned ldsw = (unsigned)wid * 1024u;
    const int aoff = lds_byte(wr * 64 + fr, fq * 8), boff = lds_byte(wc * 32 + fr, fq * 8);
#define PG8_SA(b, h) (((b) * 2 + (h)) * HTB)
#define PG8_SB(b, h) ((4 + (b) * 2 + (h)) * HTB)
#define PG8_STAGE(bufoff, gbase, voff) do { _Pragma("unroll") for (int _i = 0; _i < 2; ++_i) \
        __builtin_amdgcn_global_load_lds((const unsigned*)((const char*)(gbase) + (voff)[_i]), (PG8_LAS unsigned*)(lds + (bufoff) + ldsw + _i * 8192), 16, 0, 0); } while (0)
#define PG8_LDA(dst, b, h) do { _Pragma("unroll") for (int m = 0; m < 4; ++m) _Pragma("unroll") for (int k = 0; k < 2; ++k) dst[m][k] = *(const PG8_LAS bf16x8*)(lds + PG8_SA(b, h) + aoff + m * 2048 + k * 1024); } while (0)
#define PG8_LDB(dst, b, h) do { _Pragma("unroll") for (int n = 0; n < 2; ++n) _Pragma("unroll") for (int k = 0; k < 2; ++k) dst[n][k] = *(const PG8_LAS bf16x8*)(lds + PG8_SB(b, h) + boff + n * 2048 + k * 1024); } while (0)
#define PG8_MMA(ai, bj, At, Bt) do { __builtin_amdgcn_s_setprio(1); _Pragma("unroll") for (int m = 0; m < 4; ++m) _Pragma("unroll") for (int n = 0; n < 2; ++n) _Pragma("unroll") for (int k = 0; k < 2; ++k) \
        acc[ai][bj][m][n] = __builtin_amdgcn_mfma_f32_16x16x32_bf16(Bt[n][k], At[m][k], acc[ai][bj][m][n], 0, 0, 0); __builtin_amdgcn_s_setprio(0); } while (0)
#define PG8_WAIT_V(n) asm volatile("s_waitcnt vmcnt(" #n ")" ::: "memory")
#define PG8_WAIT_L(n) asm volatile("s_waitcnt lgkmcnt(" #n ")" ::: "memory")
#define PG8_BAR __builtin_amdgcn_s_barrier()
#define PG8_SCHED __builtin_amdgcn_sched_barrier(0)
    Unit cur, nxt; int ui = 0;
    if (!S.next(0, cur)) return;
    f32x4 acc[2][2][4][2];
#pragma unroll
    for (int a = 0; a < 2; ++a)
#pragma unroll
        for (int b = 0; b < 2; ++b)
#pragma unroll
            for (int m = 0; m < 4; ++m)
#pragma unroll
                for (int n = 0; n < 2; ++n) acc[a][b][m][n] = (f32x4){0.f, 0.f, 0.f, 0.f};
    bf16x8 At[4][2], B0[2][2], B1[2][2];
    const char* cA = (const char*)g.A + S.aoff(cur); const char* cB = (const char*)g.Bt + S.boff(cur);
    S.a_ready(cur);
    if constexpr (SP2) {
        PG8_STAGE(PG8_SB(0, 0), cB, voffB); PG8_STAGE(PG8_SB(0, 1), cB + hsB, voffB); PG8_STAGE(PG8_SA(0, 0), cA, voffA); PG8_STAGE(PG8_SA(0, 1), cA + hsA, voffA);
        if (wr == 1) PG8_BAR;
        PG8_WAIT_V(2); PG8_BAR;
        PG8_STAGE(PG8_SB(1, 0), cB + kstep, voffB); PG8_STAGE(PG8_SA(1, 0), cA + kstep, voffA); PG8_STAGE(PG8_SB(1, 1), cB + hsB + kstep, voffB);
        PG8_WAIT_V(6); PG8_BAR;
    } else {
        PG8_STAGE(PG8_SB(0, 0), cB, voffB); PG8_STAGE(PG8_SA(0, 0), cA, voffA); PG8_STAGE(PG8_SB(0, 1), cB + hsB, voffB); PG8_STAGE(PG8_SA(0, 1), cA + hsA, voffA);
        if (wr == 1) PG8_BAR;
        PG8_WAIT_V(4); PG8_BAR;
        PG8_STAGE(PG8_SB(1, 0), cB + kstep, voffB); PG8_STAGE(PG8_SA(1, 0), cA + kstep, voffA); PG8_STAGE(PG8_SB(1, 1), cB + hsB + kstep, voffB);
        PG8_WAIT_V(6); PG8_BAR;
    }
    for (;;) {
        const bool has_next = S.next(ui + 1, nxt);
        const char* nA = has_next ? (const char*)g.A + S.aoff(nxt) : cA; const char* nB = has_next ? (const char*)g.Bt + S.boff(nxt) : cB;
        for (int t = 0; t < nt; t += 2) {
            const bool last = (t == nt - 2);
            const char* a1 = cA + (size_t)(t + 1) * kstep;
            const char* a2 = last ? nA : cA + (size_t)(t + 2) * kstep; const char* b2 = last ? nB : cB + (size_t)(t + 2) * kstep;
            const char* a3 = a2 + kstep; const char* b3 = b2 + kstep;
            if (last && has_next) S.a_ready(nxt);
            if constexpr (SP2) {
            PG8_LDB(B0, 0, 0); PG8_LDB(B1, 0, 1); PG8_SCHED; PG8_LDA(At, 0, 0); PG8_STAGE(PG8_SA(1, 1), a1 + hsA, voffA);
            PG8_WAIT_V(8); PG8_WAIT_L(0); PG8_BAR; PG8_MMA(0, 0, At, B0); PG8_MMA(0, 1, At, B1); PG8_BAR; PG8_SCHED;
            PG8_LDA(At, 0, 1); PG8_STAGE(PG8_SB(0, 0), b2, voffB); PG8_STAGE(PG8_SB(0, 1), b2 + hsB, voffB); PG8_STAGE(PG8_SA(0, 0), a2, voffA);
            PG8_WAIT_V(8); PG8_WAIT_L(0); PG8_BAR; PG8_MMA(1, 0, At, B0); PG8_MMA(1, 1, At, B1); PG8_BAR; PG8_SCHED;
            PG8_LDB(B0, 1, 0); PG8_LDB(B1, 1, 1); PG8_SCHED; PG8_LDA(At, 1, 0); PG8_STAGE(PG8_SA(0, 1), a2 + hsA, voffA);
            PG8_WAIT_V(8); PG8_WAIT_L(0); PG8_BAR; PG8_MMA(0, 0, At, B0); PG8_MMA(0, 1, At, B1); PG8_BAR; PG8_SCHED;
            PG8_LDA(At, 1, 1); PG8_STAGE(PG8_SB(1, 0), b3, voffB); PG8_STAGE(PG8_SB(1, 1), b3 + hsB, voffB); PG8_STAGE(PG8_SA(1, 0), a3, voffA);
            PG8_WAIT_V(8); PG8_WAIT_L(0); PG8_BAR; PG8_MMA(1, 0, At, B0); PG8_MMA(1, 1, At, B1); PG8_BAR; PG8_SCHED;
            } else {
            PG8_LDB(B0, 0, 0); PG8_SCHED; PG8_LDA(At, 0, 0); PG8_STAGE(PG8_SA(1, 1), a1 + hsA, voffA);
            PG8_WAIT_L(8); PG8_BAR; PG8_WAIT_L(0); PG8_MMA(0, 0, At, B0); PG8_BAR; PG8_SCHED;
            PG8_LDB(B1, 0, 1); PG8_STAGE(PG8_SB(0, 0), b2, voffB);
            PG8_BAR; PG8_WAIT_L(0); PG8_MMA(0, 1, At, B1); PG8_BAR;
            PG8_LDA(At, 0, 1); PG8_STAGE(PG8_SA(0, 0), a2, voffA);
            PG8_BAR; PG8_WAIT_L(0); PG8_MMA(1, 0, At, B0); PG8_BAR; PG8_SCHED;
            PG8_STAGE(PG8_SB(0, 1), b2 + hsB, voffB);
            PG8_WAIT_V(6); PG8_BAR; PG8_MMA(1, 1, At, B1); PG8_BAR;
            PG8_LDB(B0, 1, 0); PG8_SCHED; PG8_LDA(At, 1, 0); PG8_STAGE(PG8_SA(0, 1), a2 + hsA, voffA);
            PG8_WAIT_L(8); PG8_BAR; PG8_WAIT_L(0); PG8_MMA(0, 0, At, B0); PG8_BAR; PG8_SCHED;
            PG8_LDB(B1, 1, 1); PG8_STAGE(PG8_SB(1, 0), b3, voffB);
            PG8_BAR; PG8_WAIT_L(0); PG8_MMA(0, 1, At, B1); PG8_BAR;
            PG8_LDA(At, 1, 1); PG8_STAGE(PG8_SA(1, 0), a3, voffA);
            PG8_BAR; PG8_WAIT_L(0); PG8_MMA(1, 0, At, B0); PG8_BAR; PG8_SCHED;
            PG8_STAGE(PG8_SB(1, 1), b3 + hsB, voffB);
            PG8_WAIT_V(6); PG8_BAR; PG8_MMA(1, 1, At, B1); PG8_BAR;
            }
        }
        if constexpr (ALIGN_EPI) { if (wr == 0) PG8_BAR; }
        if constexpr (!Epi::AFTER_DRAIN) { E(acc, cur, wr, wc, fr, fq); S.done(cur); }
        if (!has_next) break;
#pragma unroll
        for (int a = 0; a < 2; ++a)
#pragma unroll
            for (int b = 0; b < 2; ++b)
#pragma unroll
                for (int m = 0; m < 4; ++m)
#pragma unroll
                    for (int n = 0; n < 2; ++n) acc[a][b][m][n] = (f32x4){0.f, 0.f, 0.f, 0.f};
        cur = nxt; cA = nA; cB = nB; ++ui;
        if constexpr (ALIGN_EPI) { if (wr == 1) PG8_BAR; }
    }
    PG8_WAIT_V(0);
    if constexpr (!ALIGN_EPI) { if (wr == 0) PG8_BAR; }
    PG8_BAR;
    if constexpr (Epi::AFTER_DRAIN) { E.fused(acc, cur, wr, wc, fr, fq, lds, wid, lane); S.done(cur); }
#undef PG8_SA
#undef PG8_SB
#undef PG8_STAGE
#undef PG8_LDA
#undef PG8_LDB
#undef PG8_MMA
#undef PG8_WAIT_V
#undef PG8_WAIT_L
#undef PG8_BAR
#undef PG8_SCHED
}
}
namespace pg8 {
struct StaticOrder {
    int nM, nN, nwg, G, c, lda, ldb;
    __host__ __device__ void init(int M, int N, int G_, int c_, int lda_, int ldb_) { nM = M / BM; nN = N / BM; nwg = nM * nN; G = G_; c = c_; lda = lda_; ldb = ldb_; }
    __host__ __device__ bool next(int i, Unit& u) const {
        const long L = (long)i * G + c; if (L >= nwg) return false;
        int wgid = (int)L; { const int q = nwg / NXCD, r = nwg % NXCD, xcd = wgid % NXCD, off = wgid / NXCD; wgid = (xcd < r ? xcd * (q + 1) : r * (q + 1) + (xcd - r) * q) + off; }
        const int nig = WGM * nN, gid = wgid / nig, fm = gid * WGM, gsz = (nM - fm) < WGM ? (nM - fm) : WGM;
        u.pm = fm + ((wgid % nig) % gsz); u.pn = (wgid % nig) / gsz; return true;
    }
    __device__ __forceinline__ size_t aoff(const Unit& u) const { return (size_t)u.pm * BM * lda * 2; }
    __device__ __forceinline__ size_t boff(const Unit& u) const { return (size_t)u.pn * BM * ldb * 2; }
    __device__ __forceinline__ void a_ready(const Unit&) const {}
    __device__ __forceinline__ void done(const Unit&) const {}
};
struct InprojOrder {
    static constexpr int NCTXU = 32, NLAT = 32 * 28, NWG = NCTXU + NLAT;
    int G, c, lda, ldb; unsigned* cnt;
    __device__ __forceinline__ void init(int G_, int c_, int lda_, int ldb_, unsigned* cnt_) { G = G_; c = c_; lda = lda_; ldb = ldb_; cnt = cnt_; }
    __device__ __forceinline__ bool next(int i, Unit& u) const {
        const long L = (long)i * G + c; if (L >= NWG) return false;
        if (L < NCTXU) { const int t = (int)L & 15; u.pm = 32 + ((int)L >> 4); u.pn = t < 4 ? 4 + t : 8 + t; return true; }
        int wgid = (int)L - NCTXU; { const int q = NLAT / NXCD, xcd = wgid % NXCD, off = wgid / NXCD; wgid = xcd * q + off; }
        const int nig = WGM * 28, gid = wgid / nig, fm = gid * WGM;
        u.pm = fm + ((wgid % nig) % WGM); u.pn = (wgid % nig) / WGM; return true;
    }
    __device__ __forceinline__ size_t aoff(const Unit& u) const { return (size_t)u.pm * BM * lda * 2; }
    __device__ __forceinline__ size_t boff(const Unit& u) const { return (size_t)u.pn * BM * ldb * 2; }
    __device__ __forceinline__ void a_ready(const Unit&) const {}
    __device__ __forceinline__ void done(const Unit& u) const {
        if (!cnt || u.pm < 32) return;
        asm volatile("s_waitcnt vmcnt(0)" ::: "memory"); __syncthreads();
        if (threadIdx.x == 0) { __builtin_amdgcn_fence(__ATOMIC_RELEASE, "agent"); asm volatile("s_waitcnt vmcnt(0)" ::: "memory");
            (void)__hip_atomic_fetch_add(cnt, 1u, __ATOMIC_RELAXED, __HIP_MEMORY_SCOPE_AGENT); }
    }
};
struct FoldOrder {
    int idx, stride, lda, ldb;
    __device__ __forceinline__ bool next(int i, Unit& u) const { const int L = idx + i * stride; if (idx < 0 || L >= 64) return false; u.pm = L >> 3; u.pn = L & 7; return true; }
    __device__ __forceinline__ size_t aoff(const Unit& u) const { return (size_t)u.pm * BM * lda * 2 + (size_t)(u.pn >> 1) * 512 * 2; }
    __device__ __forceinline__ size_t boff(const Unit& u) const { return (size_t)u.pn * BM * ldb * 2; }
    __device__ __forceinline__ void a_ready(const Unit&) const {}
    __device__ __forceinline__ void done(const Unit&) const {}
};
struct EpiF32 {
    static constexpr bool PERM = false, AFTER_DRAIN = false;
    float* C; int ldc;
    __device__ __forceinline__ void operator()(const f32x4 (&acc)[2][2][4][2], const Unit& u, int wr, int wc, int fr, int fq) const {
        const int row0 = u.pm * BM + wr * 64 + fr, col0 = u.pn * BM + wc * 32 + 4 * fq;
#pragma unroll
        for (int ai = 0; ai < 2; ++ai)
#pragma unroll
            for (int m = 0; m < 4; ++m) { float* rowp = C + (size_t)(row0 + ai * HALF + m * 16) * ldc + col0;
#pragma unroll
                for (int bj = 0; bj < 2; ++bj)
#pragma unroll
                    for (int n = 0; n < 2; ++n) *(f32x4*)(rowp + bj * HALF + n * 16) = acc[ai][bj][m][n]; }
    }
};
struct EpiBf16 {
    static constexpr bool PERM = true, AFTER_DRAIN = false;
    bf16_t* O; int ldc; const float* scale; int ncolt; int silu_lo = 0, silu_hi = 0, silu_lo2 = 0, silu_hi2 = 0;
    int rope_tiles = 0, rope_rows = 0;
    __device__ __forceinline__ void operator()(const f32x4 (&acc)[2][2][4][2], const Unit& u, int wr, int wc, int fr, int fq) const {
        const int row0 = u.pm * BM + wr * 64 + fr, col0 = (u.pn % ncolt) * BM + wc * 32 + 8 * fq;
        const int ct = u.pn % ncolt; const bool act = (ct >= silu_lo && ct < silu_hi) || (ct >= silu_lo2 && ct < silu_hi2);
        const bool rp = ct < rope_tiles && u.pm * BM < rope_rows;
        float invf[4] = {0.f, 0.f, 0.f, 0.f};
        if (rp) {
#pragma unroll
            for (int j = 0; j < 4; ++j) invf[j] = __builtin_amdgcn_exp2f(-(float)(16 * (wc & 1) + 4 * fq + j) * (13.287712379549449f / 32.0f)) * 0.15915494309189535f; }
        f32x4 sv[2][2];
#pragma unroll
        for (int bj = 0; bj < 2; ++bj)
#pragma unroll
            for (int n = 0; n < 2; ++n) sv[bj][n] = scale ? *(const f32x4*)(scale + col0 + bj * HALF + 4 * n) : (f32x4){1.f, 1.f, 1.f, 1.f};
#pragma unroll
        for (int ai = 0; ai < 2; ++ai)
#pragma unroll
            for (int m = 0; m < 4; ++m) { bf16_t* rowp = O + (size_t)(row0 + ai * HALF + m * 16) * ldc + col0;
                float pos = 0.f;
                if (rp) { const int nseq = (row0 + ai * HALF + m * 16) & 4095; pos = (wc >> 1) ? (float)(nseq & 63) : (float)(nseq >> 6); }
#pragma unroll
                for (int bj = 0; bj < 2; ++bj) { f32x4 v0 = acc[ai][bj][m][0] * sv[bj][0], v1 = acc[ai][bj][m][1] * sv[bj][1];
                    if (rp) {
#pragma unroll
                        for (int j = 0; j < 4; ++j) { const float rev = pos * invf[j], rc = __builtin_amdgcn_cosf(rev), rs = __builtin_amdgcn_sinf(rev), xa = v0[j], xb = v1[j]; v0[j] = xa * rc - xb * rs; v1[j] = xb * rc + xa * rs; } }
                    if (act) {
#pragma unroll
                        for (int i = 0; i < 4; ++i) { v0[i] = v0[i] * __builtin_amdgcn_rcpf(1.f + __builtin_amdgcn_exp2f(-1.4426950408889634f * v0[i])); v1[i] = v1[i] * __builtin_amdgcn_rcpf(1.f + __builtin_amdgcn_exp2f(-1.4426950408889634f * v1[i])); } }
                    u32x4 w; w.x = cvt_pk_bf16(v0[0], v0[1]); w.y = cvt_pk_bf16(v0[2], v0[3]); w.z = cvt_pk_bf16(v1[0], v1[1]); w.w = cvt_pk_bf16(v1[2], v1[3]);
                    *(u32x4*)(rowp + bj * HALF) = w; } }
    }
};
template <unsigned N> struct PoolC { static constexpr unsigned value = N; };
struct EpiPool {
    static constexpr bool PERM = true, AFTER_DRAIN = true;
    bf16_t* MX; unsigned char* halo; unsigned* hcnt; int ldc; int tiles_per_seq;
    __device__ __forceinline__ void fused(f32x4 (&acc)[2][2][4][2], const Unit& u, int wr, int wc, int fr, int fq, PG8_LAS unsigned char* lds, int wid, int lane) const {
        const int tid = wid * 64 + lane;
        PG8_LAS unsigned char* T = lds; PG8_LAS unsigned char* HL = lds + 131072;
        const __amdgpu_buffer_rsrc_t hrs = __builtin_amdgcn_make_buffer_rsrc((void*)halo, 0, 0x7fffffff, 0x00020000);
        const unsigned hme = (unsigned)(u.pm * 8 + u.pn) * 8192u;
#pragma unroll
        for (int ai = 0; ai < 2; ++ai)
#pragma unroll
            for (int m = 0; m < 4; ++m) { const int row = ai * HALF + wr * 64 + m * 16 + fr;
#pragma unroll
                for (int bj = 0; bj < 2; ++bj) { const int ch = bj * 16 + wc * 4 + fq; const f32x4 v0 = acc[ai][bj][m][0], v1 = acc[ai][bj][m][1];
                    u32x4 w; w.x = cvt_pk_bf16(v0[0], v0[1]); w.y = cvt_pk_bf16(v0[2], v0[3]); w.z = cvt_pk_bf16(v1[0], v1[1]); w.w = cvt_pk_bf16(v1[2], v1[3]);
                    *(PG8_LAS u32x4*)(T + row * 512 + 16 * (ch ^ (row & 15))) = w;
                    if (row < 8 || row >= 248) __builtin_amdgcn_raw_buffer_store_b128(w, hrs, (int)(hme + (unsigned)((row < 8 ? row : row - 240) * 512 + ch * 16)), 0, 16); } }
        asm volatile("s_waitcnt vmcnt(0)" ::: "memory"); __syncthreads();
        if (tid == 0) __hip_atomic_fetch_add(hcnt + u.pm * 8 + u.pn, 1u, __ATOMIC_RELAXED, __HIP_MEMORY_SCOPE_AGENT);
        const int nloc = u.pm % tiles_per_seq; const bool hasup = nloc != 0, hasdn = nloc != tiles_per_seq - 1;
        const int W = 2 << (u.pn >> 1), hW = W >> 1, n0 = nloc * BM, nseq = tiles_per_seq * BM;
        auto strip_pool = [&](const int strip, const int ch, auto edge) __attribute__((always_inline)) {
            constexpr bool EDGE = decltype(edge)::value != 0u;
            const int r0 = strip * 16;
            float sum[8] = {0.f, 0.f, 0.f, 0.f, 0.f, 0.f, 0.f, 0.f};
            auto rd = [&](int q) -> u32x4 { if (EDGE) { if (q < 0) return *(const PG8_LAS u32x4*)(HL + (8 + q) * 512 + ch * 16); if (q >= BM) return *(const PG8_LAS u32x4*)(HL + (8 + q - BM) * 512 + ch * 16); }
                return *(const PG8_LAS u32x4*)(T + q * 512 + 16 * (ch ^ (q & 15))); };
            auto acc8 = [&](const u32x4 w, auto neg) { constexpr bool NEG = decltype(neg)::value != 0u;
                const float f0 = __builtin_bit_cast(float, w.x << 16), f1 = __builtin_bit_cast(float, w.x & 0xffff0000u), f2 = __builtin_bit_cast(float, w.y << 16), f3 = __builtin_bit_cast(float, w.y & 0xffff0000u),
                            f4 = __builtin_bit_cast(float, w.z << 16), f5 = __builtin_bit_cast(float, w.z & 0xffff0000u), f6 = __builtin_bit_cast(float, w.w << 16), f7 = __builtin_bit_cast(float, w.w & 0xffff0000u);
                if (NEG) { sum[0] -= f0; sum[1] -= f1; sum[2] -= f2; sum[3] -= f3; sum[4] -= f4; sum[5] -= f5; sum[6] -= f6; sum[7] -= f7; } else { sum[0] += f0; sum[1] += f1; sum[2] += f2; sum[3] += f3; sum[4] += f4; sum[5] += f5; sum[6] += f6; sum[7] += f7; } };
            auto valid = [&](int q) -> bool { if (!EDGE) return true; const int p = n0 + q; return p >= 0 && p < nseq; };
            for (int q = r0 - hW; q < r0 + hW; ++q) if (valid(q)) acc8(rd(q), PoolC<0u>{});
            bf16_t* orow = MX + (size_t)(u.pm * BM + r0) * ldc + u.pn * BM + ch * 8;
#pragma unroll 4
            for (int t = r0; t < r0 + 16; ++t) {
                float inv;
                if (EDGE) { const int plo = n0 + t - hW, phi = n0 + t + hW; inv = 1.f / (float)((phi < nseq ? phi : nseq) - (plo > 0 ? plo : 0)); } else inv = 1.f / (float)W;
                const u32x4 sv = rd(t);
                u32x4 o; o.x = cvt_pk_bf16(sum[0] * inv - __builtin_bit_cast(float, sv.x << 16), sum[1] * inv - __builtin_bit_cast(float, sv.x & 0xffff0000u)); o.y = cvt_pk_bf16(sum[2] * inv - __builtin_bit_cast(float, sv.y << 16), sum[3] * inv - __builtin_bit_cast(float, sv.y & 0xffff0000u));
                o.z = cvt_pk_bf16(sum[4] * inv - __builtin_bit_cast(float, sv.z << 16), sum[5] * inv - __builtin_bit_cast(float, sv.z & 0xffff0000u)); o.w = cvt_pk_bf16(sum[6] * inv - __builtin_bit_cast(float, sv.w << 16), sum[7] * inv - __builtin_bit_cast(float, sv.w & 0xffff0000u));
                *(u32x4*)(orow + (size_t)(t - r0) * ldc) = o;
                if (valid(t - hW)) acc8(rd(t - hW), PoolC<1u>{});
                if (valid(t + hW)) acc8(rd(t + hW), PoolC<0u>{});
            }
        };
        if (tid < 448) strip_pool(1 + (tid >> 5), tid & 31, PoolC<0u>{});
        if (tid == 0) { unsigned sp = 0;
            while ((hasup && __hip_atomic_load(hcnt + (u.pm - 1) * 8 + u.pn, __ATOMIC_RELAXED, __HIP_MEMORY_SCOPE_AGENT) < 1u) || (hasdn && __hip_atomic_load(hcnt + (u.pm + 1) * 8 + u.pn, __ATOMIC_RELAXED, __HIP_MEMORY_SCOPE_AGENT) < 1u)) {
                __builtin_amdgcn_s_sleep(2); if (++sp > (1u << 22)) break; } }
        __syncthreads();
        { const int hrow = tid >> 5, ch = tid & 31; const bool up = hrow < 8;
          if (up ? hasup : hasdn) { const unsigned src = (unsigned)((up ? u.pm - 1 : u.pm + 1) * 8 + u.pn) * 8192u + (unsigned)((up ? hrow + 8 : hrow - 8) * 512 + ch * 16);
              *(PG8_LAS u32x4*)(HL + hrow * 512 + ch * 16) = __builtin_amdgcn_raw_buffer_load_b128(hrs, (int)src, 0, 16); } }
        __syncthreads();
        if (tid < 64) strip_pool((tid >> 5) ? 15 : 0, tid & 31, PoolC<1u>{});
    }
};
struct EpiSwiglu {
    static constexpr bool PERM = true, AFTER_DRAIN = false;
    bf16_t* H;
    __device__ __forceinline__ void operator()(const f32x4 (&acc)[2][2][4][2], const Unit& u, int wr, int wc, int fr, int fq) const {
        const int row0 = u.pm * BM + wr * 64 + fr, col0 = (u.pn & 3) * 128 + wc * 32 + 8 * fq;
#pragma unroll
        for (int ai = 0; ai < 2; ++ai)
#pragma unroll
            for (int m = 0; m < 4; ++m) { bf16_t* rowp = H + (size_t)(row0 + ai * HALF + m * 16) * 512 + col0;
                float h[8];
#pragma unroll
                for (int n = 0; n < 2; ++n)
#pragma unroll
                    for (int i = 0; i < 4; ++i) { const float a = acc[ai][0][m][n][i], b = acc[ai][1][m][n][i]; h[n * 4 + i] = a * __builtin_amdgcn_rcpf(1.f + __builtin_amdgcn_exp2f(-1.4426950408889634f * a)) * b; }
                u32x4 w; w.x = cvt_pk_bf16(h[0], h[1]); w.y = cvt_pk_bf16(h[2], h[3]); w.z = cvt_pk_bf16(h[4], h[5]); w.w = cvt_pk_bf16(h[6], h[7]);
                asm volatile("global_store_dwordx4 %0, %1, off sc1\n\ts_nop 1" :: "v"(rowp), "v"(w) : "memory"); }
    }
};
}
namespace pg8 {
__device__ __forceinline__ unsigned bimg(unsigned k, unsigned n) { return 512u * k + 16u * ((n >> 3) ^ (((k & 3u) << 2) | ((k >> 2) & 3u))) + 2u * (n & 7u); }
#define PG8_TR2(d0, d1, a0, a1, OFF) asm volatile("ds_read_b64_tr_b16 %0, %2 offset:" #OFF "\n\tds_read_b64_tr_b16 %1, %3 offset:" #OFF : "=&v"(d0), "=&v"(d1) : "v"(a0), "v"(a1) : "memory")
typedef unsigned short u16x4 __attribute__((ext_vector_type(4)));
__device__ __forceinline__ bf16x8 cat44(u16x4 lo, u16x4 hi) { bf16x8 r; r[0] = (short)lo[0]; r[1] = (short)lo[1]; r[2] = (short)lo[2]; r[3] = (short)lo[3]; r[4] = (short)hi[0]; r[5] = (short)hi[1]; r[6] = (short)hi[2]; r[7] = (short)hi[3]; return r; }

struct MoeCfg { const bf16_t* A; int lda; const int* arow; int K; const float* W0; const float* W1; int ldn; size_t estride; int colstep; int NT; };
struct FusedOrder {
    const PG8_LAS int* tab; int G, c, T;
    __device__ __forceinline__ void init(const PG8_LAS int* tab_, int G_, int c_) { tab = tab_; G = G_; c = c_; int t = 0; _Pragma("unroll 1") for (int e = 0; e < 32; ++e) t += tab[e]; T = t; }
    __device__ __forceinline__ bool unit(int L, int NT, Unit& u) const {
        int acc = 0, e = 0, n = 0;
#pragma unroll 1
        for (; e < 32; ++e) { n = tab[e]; if (L < NT * (acc + n)) break; acc += n; }
        if (e >= 32) return false;
        const int q = L - NT * acc, j = q / n, t = acc + (q - j * n);
        u.pm = t; u.pn = e * NT + j; return true;
    }
    __device__ __forceinline__ bool next(int i, Unit& u, int& type, int& kh, int& ub) const {
        const int nU = 4 * T, R0 = (nU + G - 1) / G; int nFull = nU;
        if (R0 > 1 && 2 * (nU - G * (R0 - 1)) <= G) nFull = G * (R0 - 1);
        const int nG1 = nFull + 2 * (nU - nFull), nG2 = 8 * T, R = (nG1 + G - 1) / G, nH = nG1 - G * (R - 1), nL = G - nH, CU = 3;
        const int n1 = (c < nG1) ? ((nG1 - 1 - c) / G + 1) : 0; const bool light = n1 < R;
        kh = -1; ub = 0;
        if (i < n1) { int L = c + G * i; type = 0;
            if (L >= nFull) { const int Lb = L - nFull; kh = Lb & 1; ub = Lb >> 1; L = nFull + ub; }
            return unit(L, 4, u); }
        const int i2 = i - n1; int u2;
        if (light && i2 < CU) u2 = i2 * nL + (c - nH); else u2 = CU * nL + c + G * (i2 - (light ? CU : 0));
        if (u2 >= nG2) return false;
        type = 1;
        return unit(u2, 8, u);
    }
};
template <int MODE, class EpiA, class EpiB>
__device__ __forceinline__ bool moe_run(PG8_LAS unsigned char* lds, const MoeCfg& c0, const MoeCfg& c1, unsigned* mcnt, unsigned char* xbuf, unsigned* xcnt, const FusedOrder& S, const EpiA& EA, const EpiB& EB,
                                        int& ui, Unit& cur, int& type, int& kh, int& ub) {
    typedef EpiA Epi;
    constexpr bool T1 = MODE == 2, SPLIT = MODE == 1;
#define F_SA(b, h) (((b) * 2 + (h)) * 8192)
#define F_SB(b) (32768 + (b) * 16384)
#define F_UNIFORM() do { cur.pm = __builtin_amdgcn_readfirstlane(cur.pm); cur.pn = __builtin_amdgcn_readfirstlane(cur.pn); type = __builtin_amdgcn_readfirstlane(type); kh = __builtin_amdgcn_readfirstlane(kh); ub = __builtin_amdgcn_readfirstlane(ub); } while (0)
    for (;;) {
        if ((type ? 2 : (kh >= 0 ? 1 : 0)) != MODE) return true;
    int tz_ = threadIdx.x; asm volatile("" : "+v"(tz_));
    const int tid = tz_, wid = __builtin_amdgcn_readfirstlane(tid >> 6), lane = tid & 63, wr = wid >> 2, wc = wid & 3, fr = lane & 15, fq = lane >> 4;
    int RA, CA; { const int b_ = tid * 16, st = b_ / 1024, sb = b_ % 1024, swz = sb ^ (((sb >> 9) & 1) << 5); RA = st * 16 + swz / 64; CA = (swz % 64) / 2; }
    const int aoff = ((wr * 64 + fr) >> 4) * 1024 + (((fr & 15) * 64 + fq * 16) ^ (((((fr & 15) * 64 + fq * 16) >> 9) & 1) << 5));
    const int n4 = tid & 63, kr = tid >> 6;
    int wcol; { const int a = n4 & 7, g32 = (n4 & 31) >> 3; wcol = Epi::PERM ? (32 * g32 + 8 * (a & 3) + 4 * (a >> 2)) : 4 * (n4 & 31); }
    const bool hi_half = n4 >= 32;
    unsigned bta[4];
    { const unsigned q = (lane & 15) >> 2, p = lane & 3, g = lane >> 4;
#pragma unroll
      for (int n = 0; n < 2; ++n)
#pragma unroll
          for (int t = 0; t < 2; ++t) { const unsigned row = 8 * g + 4 * t + q, ch = (unsigned)(32 * wc + 16 * n) / 8 + (p >> 1);
              bta[n * 2 + t] = 512u * row + 16u * (ch ^ (((row & 3u) << 2) | ((row >> 2) & 3u))) + 8u * (p & 1); } }
        const bf16_t* A = T1 ? c1.A : c0.A; const int lda = T1 ? c1.lda : c0.lda; const int* arow = T1 ? c1.arow : c0.arow; const int nst_all = (T1 ? c1.K : c0.K) / 32, nst = SPLIT ? nst_all / 2 : nst_all, kb = (SPLIT && kh > 0) ? nst : 0;
        const float* W0 = T1 ? c1.W0 : c0.W0; const float* W1 = T1 ? c1.W1 : c0.W1; const int ldn = T1 ? c1.ldn : c0.ldn; const size_t estride = T1 ? c1.estride : c0.estride; const int colstep = T1 ? c1.colstep : c0.colstep, NT = T1 ? c1.NT : c0.NT;
        if constexpr (T1) {
            if (tid == 0) { unsigned sp = 0; while (__hip_atomic_load(mcnt + cur.pm, __ATOMIC_RELAXED, __HIP_MEMORY_SCOPE_AGENT) < 4u) { __builtin_amdgcn_s_sleep(2); if (++sp > (1u << 22)) break; } }
            __syncthreads();
        }
        f32x4 acc[2][2][4][2];
#pragma unroll
        for (int x = 0; x < 2; ++x)
#pragma unroll
            for (int y = 0; y < 2; ++y)
#pragma unroll
                for (int m = 0; m < 4; ++m)
#pragma unroll
                    for (int n = 0; n < 2; ++n) acc[x][y][m][n] = (f32x4){0.f, 0.f, 0.f, 0.f};
        unsigned ao[2];
#pragma unroll
        for (int h = 0; h < 2; ++h) { const int r = cur.pm * BM + h * HALF + RA; int srow = r;
            if (arow) { srow = arow[r]; srow = ((unsigned)srow < 8192u) ? srow : 0; }
            ao[h] = ((unsigned)srow * (unsigned)lda + (unsigned)CA) * 2u + (unsigned)kb * 64u; }
        const int e = cur.pn / NT, j = cur.pn - e * NT;
        const float* wp = (hi_half ? W1 : W0) + (size_t)e * estride + (size_t)j * colstep + wcol + ((size_t)kr + (size_t)kb * 32) * ldn;
        const __amdgpu_buffer_rsrc_t hrs = __builtin_amdgcn_make_buffer_rsrc((void*)c1.A, 0, 0x7fffffff, 0x00020000);
        f32x4 wv0[4], wv1[4]; u32x4 av0[2], av1[2];
#define F_ISSUE(AV, WV, kt) do { if constexpr (T1) { _Pragma("unroll") for (int h = 0; h < 2; ++h) AV[h] = __builtin_amdgcn_raw_buffer_load_b128(hrs, (int)(ao[h] + (unsigned)(kt) * 64u), 0, 16); } \
            else { _Pragma("unroll") for (int h = 0; h < 2; ++h) AV[h] = *(const __attribute__((address_space(1))) u32x4*)((const char*)A + (ao[h] + (unsigned)(kt) * 64u)); } \
            _Pragma("unroll") for (int i = 0; i < 4; ++i) WV[i] = *(const __attribute__((address_space(1))) f32x4*)(wp + ((size_t)(kt) * 32 + 8 * i) * ldn); } while (0)
#define F_WRITE(AV, WV, b) do { _Pragma("unroll") for (int h = 0; h < 2; ++h) *(PG8_LAS u32x4*)(lds + F_SA(b, h) + tid * 16) = AV[h]; \
            _Pragma("unroll") for (int i = 0; i < 4; ++i) { typedef unsigned u32x2 __attribute__((ext_vector_type(2))); \
            *(PG8_LAS u32x2*)(lds + F_SB(b) + bimg(kr + 8 * i, 4 * n4)) = (u32x2){cvt_pk_bf16(WV[i][0], WV[i][1]), cvt_pk_bf16(WV[i][2], WV[i][3])}; } } while (0)
#define F_COMPUTE(b) do { const unsigned bb = (unsigned)(size_t)(lds + F_SB(b)); \
            _Pragma("unroll") for (int bj = 0; bj < 2; ++bj) { typedef short s16x4 __attribute__((ext_vector_type(4))); \
                const s16x4 d0 = __builtin_amdgcn_ds_read_tr16_b64_v4i16((PG8_LAS s16x4*)(size_t)(bb + bta[0] + 256 * bj)), d1 = __builtin_amdgcn_ds_read_tr16_b64_v4i16((PG8_LAS s16x4*)(size_t)(bb + bta[1] + 256 * bj)); \
                const s16x4 d2 = __builtin_amdgcn_ds_read_tr16_b64_v4i16((PG8_LAS s16x4*)(size_t)(bb + bta[2] + 256 * bj)), d3 = __builtin_amdgcn_ds_read_tr16_b64_v4i16((PG8_LAS s16x4*)(size_t)(bb + bta[3] + 256 * bj)); \
                const bf16x8 B0 = __builtin_shufflevector(d0, d1, 0, 1, 2, 3, 4, 5, 6, 7), B1 = __builtin_shufflevector(d2, d3, 0, 1, 2, 3, 4, 5, 6, 7); \
                _Pragma("unroll") for (int ai = 0; ai < 2; ++ai) { bf16x8 Af[4]; \
                    _Pragma("unroll") for (int m = 0; m < 4; ++m) Af[m] = *(const PG8_LAS bf16x8*)(lds + F_SA(b, ai) + aoff + m * 1024); \
                    __builtin_amdgcn_s_setprio(1); \
                    _Pragma("unroll") for (int m = 0; m < 4; ++m) { acc[ai][bj][m][0] = __builtin_amdgcn_mfma_f32_16x16x32_bf16(B0, Af[m], acc[ai][bj][m][0], 0, 0, 0); \
                                                                     acc[ai][bj][m][1] = __builtin_amdgcn_mfma_f32_16x16x32_bf16(B1, Af[m], acc[ai][bj][m][1], 0, 0, 0); } \
                    __builtin_amdgcn_s_setprio(0); } } } while (0)
#define F_SYNC() do { asm volatile("s_waitcnt lgkmcnt(0)" ::: "memory"); __builtin_amdgcn_s_barrier(); } while (0)
        F_ISSUE(av0, wv0, 0); F_ISSUE(av1, wv1, 1);
        F_WRITE(av0, wv0, 0);
        F_SYNC();
        for (int t = 0; t < nst; t += 2) {
            F_ISSUE(av0, wv0, (t + 2 < nst) ? t + 2 : nst - 1);
            __builtin_amdgcn_sched_barrier(0);
            F_COMPUTE(0);
            __builtin_amdgcn_sched_barrier(0);
            F_WRITE(av1, wv1, 1);
            asm volatile("s_waitcnt lgkmcnt(0)" ::: "memory"); __builtin_amdgcn_s_barrier();
            F_ISSUE(av1, wv1, (t + 3 < nst) ? t + 3 : nst - 1);
            __builtin_amdgcn_sched_barrier(0);
            F_COMPUTE(1);
            __builtin_amdgcn_sched_barrier(0);
            F_WRITE(av0, wv0, 0);
            asm volatile("s_waitcnt lgkmcnt(0)" ::: "memory"); __builtin_amdgcn_s_barrier();
        }
        if constexpr (SPLIT) {
            const unsigned xo = (unsigned)tid * 16u;
            const __amdgpu_buffer_rsrc_t xrs = __builtin_amdgcn_make_buffer_rsrc((void*)(xbuf + (size_t)ub * 1048576), 0, 1048576, 0x00020000);
            const int hb = kh * 524288;
#pragma unroll
            for (int x = 0; x < 2; ++x)
#pragma unroll
                for (int y = 0; y < 2; ++y)
#pragma unroll
                    for (int m = 0; m < 4; ++m)
#pragma unroll
                        for (int n = 0; n < 2; ++n) __builtin_amdgcn_raw_buffer_store_b128(__builtin_bit_cast(u32x4, acc[x][y][m][n]), xrs, (int)xo, hb + (((x * 2 + y) * 4 + m) * 2 + n) * 8192, 16);
            asm volatile("s_waitcnt vmcnt(0)" ::: "memory"); __syncthreads();
            if (tid == 0) __hip_atomic_fetch_add(xcnt + ub, 1u, __ATOMIC_RELAXED, __HIP_MEMORY_SCOPE_AGENT);
            if (kh == 1) {
                if (tid == 0) { unsigned sp = 0; while (__hip_atomic_load(xcnt + ub, __ATOMIC_RELAXED, __HIP_MEMORY_SCOPE_AGENT) < 2u) { __builtin_amdgcn_s_sleep(2); if (++sp > (1u << 22)) break; } }
                __syncthreads();
                const int row0 = cur.pm * BM + wr * 64 + fr, col0 = (cur.pn & 3) * 128 + wc * 32 + 8 * fq;
#pragma unroll 1
                for (int am = 0; am < 8; ++am) { const int ai = am >> 2, m = am & 3;
                    f32x4 pa[2][2], pb[2][2];
#pragma unroll
                    for (int n = 0; n < 2; ++n)
#pragma unroll
                        for (int hf = 0; hf < 2; ++hf) { pa[n][hf] = __builtin_bit_cast(f32x4, __builtin_amdgcn_raw_buffer_load_b128(xrs, (int)xo, hf * 524288 + (((ai * 2 + 0) * 4 + m) * 2 + n) * 8192, 16));
                                                          pb[n][hf] = __builtin_bit_cast(f32x4, __builtin_amdgcn_raw_buffer_load_b128(xrs, (int)xo, hf * 524288 + (((ai * 2 + 1) * 4 + m) * 2 + n) * 8192, 16)); }
                    float h[8];
#pragma unroll
                    for (int n = 0; n < 2; ++n)
#pragma unroll
                        for (int i = 0; i < 4; ++i) { const float ga = pa[n][0][i] + pa[n][1][i], gb = pb[n][0][i] + pb[n][1][i]; h[n * 4 + i] = ga * __builtin_amdgcn_rcpf(1.f + __builtin_amdgcn_exp2f(-1.4426950408889634f * ga)) * gb; }
                    u32x4 w; w.x = cvt_pk_bf16(h[0], h[1]); w.y = cvt_pk_bf16(h[2], h[3]); w.z = cvt_pk_bf16(h[4], h[5]); w.w = cvt_pk_bf16(h[6], h[7]);
                    bf16_t* rowp = EA.H + (size_t)(row0 + ai * HALF + m * 16) * 512 + col0;
                    asm volatile("global_store_dwordx4 %0, %1, off sc1\n\ts_nop 1" :: "v"(rowp), "v"(w) : "memory"); }
                asm volatile("s_waitcnt vmcnt(0)" ::: "memory"); __syncthreads();
                if (tid == 0) __hip_atomic_fetch_add(mcnt + cur.pm, 1u, __ATOMIC_RELAXED, __HIP_MEMORY_SCOPE_AGENT); }
        } else if constexpr (!T1) {
            EA(acc, cur, wr, wc, fr, fq);
            asm volatile("s_waitcnt vmcnt(0)" ::: "memory"); __syncthreads();
            if (tid == 0) __hip_atomic_fetch_add(mcnt + cur.pm, 1u, __ATOMIC_RELAXED, __HIP_MEMORY_SCOPE_AGENT); }
        else EB(acc, cur, wr, wc, fr, fq);
        ++ui;
        if (!S.next(ui, cur, type, kh, ub)) return false;
        F_UNIFORM();
    }
#undef F_UNIFORM
#undef F_SA
#undef F_SB
#undef F_ISSUE
#undef F_WRITE
#undef F_COMPUTE
#undef F_SYNC
}
template <class EpiA, class EpiB>
__device__ __forceinline__ void gemm_moe_fused(PG8_LAS unsigned char* lds, const MoeCfg c0, const MoeCfg c1, unsigned* mcnt, unsigned char* xbuf, unsigned* xcnt, const FusedOrder& S, const EpiA& EA, const EpiB& EB) {
    Unit cur; int ui = 0, type = 0, kh = -1, ub = 0;
    if (!S.next(0, cur, type, kh, ub)) return;
    cur.pm = __builtin_amdgcn_readfirstlane(cur.pm); cur.pn = __builtin_amdgcn_readfirstlane(cur.pn); type = __builtin_amdgcn_readfirstlane(type); kh = __builtin_amdgcn_readfirstlane(kh); ub = __builtin_amdgcn_readfirstlane(ub);
    if (!moe_run<0, EpiA, EpiB>(lds, c0, c1, mcnt, xbuf, xcnt, S, EA, EB, ui, cur, type, kh, ub)) return;
    if (!moe_run<1, EpiA, EpiB>(lds, c0, c1, mcnt, xbuf, xcnt, S, EA, EB, ui, cur, type, kh, ub)) return;
    (void)moe_run<2, EpiA, EpiB>(lds, c0, c1, mcnt, xbuf, xcnt, S, EA, EB, ui, cur, type, kh, ub);
}
}
constexpr int D = 2048, SEQ = 4096, NTOK = 8192, CTXL = 256, NCTX = 512, MROWS = NTOK + NCTX;
constexpr int MIXW = 7168;
constexpr int C_Q = 0, C_K = 1024, C_V = 1536, C_HQ = 2048, C_FF = 3072, C_FB = 4096, C_HI = 5120, C_HG = 6144;
constexpr int NEXP = 32, FF = 512;
constexpr float ALPHA = 1.41421356237309515f, LN_EPS = 1e-5f, NORM_EPS = 1e-6f;
constexpr int NWAVES = 8, NTHR = 512;
constexpr int XEROWS = 2 * NTOK + NEXP * 256;
constexpr size_t MiB = 1u << 20;
constexpr size_t WS_CTL = 0, CTL_ZERO_BYTES = 1 * MiB;
constexpr size_t WS_SMALL = 1 * MiB;
constexpr size_t WS_WIN = 4 * MiB;
constexpr size_t WS_WOUT = WS_WIN + (size_t)MIXW * D * 2;
constexpr size_t WS_WPIN = WS_WOUT + (size_t)D * D * 2;
constexpr size_t WS_WPOUT = WS_WPIN + (size_t)D * D * 2;
constexpr size_t WS_WGRP = WS_WPOUT + (size_t)D * D * 2;
constexpr size_t WS_W13 = WS_WGRP + (size_t)4 * 512 * 512 * 2;
constexpr size_t WS_W16 = WS_W13;
constexpr size_t WS_WFOLD = WS_W13 + 1 * MiB;
constexpr size_t WS_HALO = WS_W13 + 16 * MiB;
constexpr size_t WS_XBUF = WS_W13 + 32 * MiB;
constexpr size_t WS_W2 = WS_W13 + (size_t)2 * NEXP * 1024 * D * 2;
constexpr size_t WS_REGA = WS_W2 + (size_t)2 * NEXP * D * FF * 2;
constexpr size_t REGA_BYTES = (size_t)MROWS * MIXW * 2;
constexpr size_t WS_REGB = WS_REGA + REGA_BYTES;
constexpr size_t REGB_BYTES = (size_t)XEROWS * D * 2;
constexpr size_t WS_HX = WS_REGB + REGB_BYTES;
constexpr size_t WS_CAT = WS_HX + (size_t)MROWS * D * 2;
constexpr size_t WS_H = WS_CAT + (size_t)NTOK * D * 2;
constexpr size_t WS_YX = WS_H + (size_t)XEROWS * FF * 2;
constexpr size_t WS_X1 = WS_YX + (size_t)NTOK * D * 4;
constexpr size_t WS_X2 = WS_X1 + (size_t)NTOK * D * 4;
constexpr size_t WS_TOK = WS_X2 + (size_t)NTOK * D * 4;
constexpr size_t WS_END = WS_TOK + (size_t)NTOK * D * 2;
static_assert(WS_XBUF + (size_t)248 * 1048576 <= WS_REGA, "xbuf");
static_assert((size_t)XEROWS * D * 2 <= REGA_BYTES && (size_t)3 * NTOK * D * 2 <= REGA_BYTES && (size_t)2 * NTOK * 1024 * 4 <= REGB_BYTES, "aliases");
constexpr int CW_TMO = 0, CW_CNT = 64, CW_BAR = 4096, CW_MCNT = 200000  , CW_GVQ = 203584  , CW_HCNT = 203136  , CW_XCNT = 202048  , CW_INARR = 201024  ;
constexpr int SM_MOD = 0;
constexpr int SM_MC = SM_MOD + 2 * 2 * 6 * D;
constexpr int SM_LB = SM_MC + 6 * D;
constexpr int SM_TOKE = SM_LB + 2 * 1024;
constexpr int SM_TOKR = SM_TOKE + 2 * NTOK;
constexpr int SM_TOKG = SM_TOKR + 2 * NTOK;
constexpr int SM_TOKS = SM_TOKG + 2 * NTOK;
constexpr int SM_BCNT = SM_TOKS + 2 * NTOK;
constexpr int SM_SLOTTOK = SM_BCNT + 2 * 256 * 32;
constexpr int SM_END = SM_SLOTTOK + XEROWS;
static_assert((size_t)SM_END * 4 <= 3 * MiB, "small");
constexpr int RING_BYTES = 131072, LDS_CTLB = 162816  , LDS_TAB = LDS_CTLB  , LDS_MISC = LDS_CTLB + 512, LDS_BYTES = 163840;

#define GAS __attribute__((address_space(1)))
#define LAS __attribute__((address_space(3)))
typedef unsigned short bf16;
typedef unsigned v4u __attribute__((ext_vector_type(4)));
typedef unsigned v2u __attribute__((ext_vector_type(2)));
typedef float f32x4 __attribute__((ext_vector_type(4)));
typedef float f32x2v __attribute__((ext_vector_type(2)));
#define LDS_WAIT() asm volatile("s_waitcnt lgkmcnt(0)" ::: "memory")
#define VM_WAIT() asm volatile("s_waitcnt vmcnt(0)" ::: "memory")
__device__ __forceinline__ unsigned f2bf(float f) { unsigned u = __builtin_bit_cast(unsigned, f); return (u + 0x7fffu + ((u >> 16) & 1u)) >> 16; }
__device__ __forceinline__ unsigned pk2(float lo, float hi) { return f2bf(lo) | (f2bf(hi) << 16); }
__device__ __forceinline__ float bf2f(unsigned h) { return __builtin_bit_cast(float, h << 16); }
__device__ __forceinline__ float bflo(unsigned w) { return __builtin_bit_cast(float, w << 16); }
__device__ __forceinline__ float bfhi(unsigned w) { return __builtin_bit_cast(float, w & 0xffff0000u); }
__device__ __forceinline__ float sigmoid_f(float x) { return 1.f / (1.f + expf(-x)); }
__device__ __forceinline__ float silu_f(float x) { return x / (1.f + expf(-x)); }
__device__ __forceinline__ float fsigmoid(float x) { return __builtin_amdgcn_rcpf(1.f + __builtin_amdgcn_exp2f(-1.4426950408889634f * x)); }
__device__ __forceinline__ float fsilu(float x) { return x * fsigmoid(x); }
__device__ __forceinline__ float wave_sum(float v) {
    v += __builtin_bit_cast(float, __builtin_amdgcn_update_dpp(0, __builtin_bit_cast(int, v), 0xB1, 0xf, 0xf, true));
    v += __builtin_bit_cast(float, __builtin_amdgcn_update_dpp(0, __builtin_bit_cast(int, v), 0x4E, 0xf, 0xf, true));
    v += __builtin_bit_cast(float, __builtin_amdgcn_update_dpp(0, __builtin_bit_cast(int, v), 0x141, 0xf, 0xf, true));
    v += __builtin_bit_cast(float, __builtin_amdgcn_update_dpp(0, __builtin_bit_cast(int, v), 0x140, 0xf, 0xf, true));
    v += __builtin_bit_cast(float, __builtin_amdgcn_update_dpp(0, __builtin_bit_cast(int, v), 0x142, 0xa, 0xf, false));
    v += __builtin_bit_cast(float, __builtin_amdgcn_update_dpp(0, __builtin_bit_cast(int, v), 0x143, 0xc, 0xf, false));
    return __builtin_bit_cast(float, __builtin_amdgcn_readlane(__builtin_bit_cast(int, v), 63));
}
#define XB_TMO      128
#define XB_XCNT(j)  (256  + 64 * (j))
#define XB_XSUB(j)  (1280 + 64 * (j))
#define XB_XGEN(j)  (2304 + 64 * (j))
#define XB_TOP      3328
#define XB_TOPGEN   3392
#define XCD_BAR_WORDS 3456
#define XB_SPIN_CAP (1u << 18)

__device__ __forceinline__ unsigned xb_ld(unsigned* p)              { return __hip_atomic_load(p, __ATOMIC_RELAXED, __HIP_MEMORY_SCOPE_AGENT); }
__device__ __forceinline__ unsigned xb_add(unsigned* p, unsigned v) { return __hip_atomic_fetch_add(p, v, __ATOMIC_RELAXED, __HIP_MEMORY_SCOPE_AGENT); }
__device__ __forceinline__ unsigned xb_xcc_id() { return (unsigned)__builtin_amdgcn_s_getreg((3 << 11) | 20) & 0xFu; }
#define XB_SPIN(cond, bar) do { unsigned _sp = 0; while (cond) { __builtin_amdgcn_s_sleep(1); \
    if ((++_sp & 255u) == 0u) { if (xb_ld(&(bar)[XB_TMO])) break; if (_sp > XB_SPIN_CAP) { atomicAdd(&(bar)[XB_TMO], 1u); break; } } } } while (0)

struct XcdBarrier {
    unsigned* bar; unsigned x;
    volatile LAS unsigned* st;
};

__device__ __forceinline__ XcdBarrier xcd_barrier_post(unsigned* bar, volatile LAS unsigned* st) {
    XcdBarrier b; b.bar = bar; b.x = xb_xcc_id(); b.st = st;
    if (threadIdx.x == 0) (void)xb_add(&bar[XB_XCNT(b.x)], 1u);
    return b;
}
__device__ __forceinline__ void xcd_barrier_complete(unsigned* bar, unsigned x, unsigned& nloc, unsigned& nx) {
    const unsigned G = gridDim.x * gridDim.y * gridDim.z;
    unsigned sum, cnt, mine, sp = 0u;
    for (;;) {
        sum = 0u; cnt = 0u; mine = 0u;
#pragma unroll
        for (unsigned j = 0; j < 16; ++j) { const unsigned c = xb_ld(&bar[XB_XCNT(j)]); sum += c; cnt += (c > 0u) ? 1u : 0u; mine = (j == x) ? c : mine; }
        if (sum == G) break;
        __builtin_amdgcn_s_sleep(1);
        if ((++sp & 255u) == 0u) { if (xb_ld(&bar[XB_TMO])) break; if (sp > XB_SPIN_CAP) { atomicAdd(&bar[XB_TMO], 1u); break; } }
    }
    nloc = mine > 0u ? mine : 1u; nx = cnt > 0u ? cnt : 1u;
}

__device__ __forceinline__ void xcd_barrier(const XcdBarrier& b) {
    asm volatile("s_waitcnt vmcnt(0)" ::: "memory");
    __syncthreads();
    if (threadIdx.x == 0) {
        unsigned* bar = b.bar;
        __builtin_amdgcn_s_waitcnt(0);
        unsigned nloc = b.st[0], nx = b.st[1];
        if (nloc == 0u) { xcd_barrier_complete(bar, b.x, nloc, nx); b.st[0] = nloc; b.st[1] = nx; }
        const unsigned old = xb_add(&bar[XB_XSUB(b.x)], 1u);
        const unsigned gen = old / nloc;
        if (old + 1u == (gen + 1u) * nloc) {
            __builtin_amdgcn_fence(__ATOMIC_RELEASE, "agent");
            asm volatile("s_waitcnt vmcnt(0)" ::: "memory");
            const unsigned og = xb_add(&bar[XB_TOP], 1u);
            const unsigned tg = og / nx;
            if (og + 1u == (tg + 1u) * nx) xb_add(&bar[XB_TOPGEN], 1u);
            else XB_SPIN(xb_ld(&bar[XB_TOPGEN]) == tg, bar);
            __builtin_amdgcn_fence(__ATOMIC_ACQUIRE, "agent");
            xb_add(&bar[XB_XGEN(b.x)], 1u);
            asm volatile("s_waitcnt vmcnt(0)" ::: "memory");
        } else {
            XB_SPIN(xb_ld(&bar[XB_XGEN(b.x)]) == gen, bar);
            __builtin_amdgcn_fence(__ATOMIC_ACQUIRE, "agent");
            asm volatile("s_waitcnt vmcnt(0)" ::: "memory");
        }
    }
    __syncthreads();
}
struct Args { const float* in[24]; float* out; unsigned char* ws; int ph_lo, ph_hi; };
struct Ctx {
    LAS unsigned char* lds; int tid, lane, wave, vcu, G;
};

__device__ __forceinline__ void tr_item(const float* W, int K, int N, bf16* WT, int k0, int n0, int drow0, LAS float* scr, int lane, bool rperm = false) {
    const int kr = lane >> 4, n4 = (lane & 15) * 4;
#pragma unroll 8
    for (int i = 0; i < 16; ++i) { const int kk = 4 * i + kr; const f32x4 v = *(const GAS f32x4*)(W + (size_t)(k0 + kk) * N + n0 + n4);
        LAS float* s = scr + kk * 65 + n4; s[0] = v[0]; s[1] = v[1]; s[2] = v[2]; s[3] = v[3]; }
    LDS_WAIT();
    const int c = lane & 7;
#pragma unroll
    for (int j = 0; j < 8; ++j) { const int n = (lane >> 3) + 8 * j, ns = rperm ? (4 * (n >> 3) + (n & 3) + 32 * ((n >> 2) & 1)) : n; const LAS float* s = scr + (8 * c) * 65 + ns;
        v4u o; o.x = pk2(s[0 * 65], s[1 * 65]); o.y = pk2(s[2 * 65], s[3 * 65]); o.z = pk2(s[4 * 65], s[5 * 65]); o.w = pk2(s[6 * 65], s[7 * 65]);
        *(GAS v4u*)(WT + (size_t)(drow0 + n) * K + k0 + 8 * c) = o; }
    LDS_WAIT();
}
__device__ __forceinline__ void p0_convert(const Ctx& F, const Args& a, int me, int nb, bool late, int gemv_wgs = 0) {
    unsigned char* ws = a.ws;
    LAS float* scr = (LAS float*)(F.lds + F.wave * 16640);
    const int gw = me * NWAVES + F.wave, NGW = nb * NWAVES;
    constexpr int I_IN = 32 * (MIXW / 64), I_SQ = 32 * 32, I_GRP = 4 * 64, I_MOE = 64 * 768;
    constexpr int NITEMS = I_IN + 1 * I_SQ + I_GRP;
    if (me < 0 || me >= nb) return;
    if (late) { for (int r = gw; r < I_SQ; r += NGW) tr_item(a.in[13], D, D, (bf16*)(ws + WS_WPIN), 64 * (r / 32), 64 * (r % 32), 64 * (r % 32), scr, F.lane); return; }
    if (gemv_wgs < 0) {
        for (int r = gw; r < I_SQ; r += NGW) tr_item(a.in[12], D, D, (bf16*)(ws + WS_WOUT), 64 * (r / 32), 64 * (r % 32), 64 * (r % 32), scr, F.lane); return; }
    const int gb = gemv_wgs < nb ? gemv_wgs : nb, shares = me < gb ? 1 : 2, vbase = me < gb ? me * NWAVES : gb * NWAVES + (me - gb) * 2 * NWAVES, vtot = gb * NWAVES + (nb - gb) * 2 * NWAVES;
    for (int sh = 0; sh < shares; ++sh)
    for (int it = vbase + sh * NWAVES + F.wave; it < NITEMS; it += vtot) {
        int r = it;
        if (r < I_IN) { const int nb = MIXW / 64; tr_item(a.in[8], D, MIXW, (bf16*)(ws + WS_WIN), 64 * (r / nb), 64 * (r % nb), 64 * (r % nb), scr, F.lane, 64 * (r % nb) < C_V); continue; } r -= I_IN;
        if (r < I_SQ) { tr_item(a.in[16], D, D, (bf16*)(ws + WS_WPOUT), 64 * (r / 32), 64 * (r % 32), 64 * (r % 32), scr, F.lane); continue; } r -= I_SQ;
        if (r < I_GRP) { const int g = r / 64, ii = r % 64, c0 = 64 * (ii / 8), j0 = 64 * (ii % 8) + 4 * (F.lane & 15);
            const f32x4 sc = *(const GAS f32x4*)(a.in[15] + 512 * g + j0);
#pragma unroll 4
            for (int i = 0; i < 16; ++i) { const size_t e = ((size_t)g * 512 + c0 + 4 * i + (F.lane >> 4)) * 512 + j0; const f32x4 v = *(const GAS f32x4*)(a.in[14] + e) * sc;
                *(GAS v2u*)((bf16*)(ws + WS_WGRP) + e) = (v2u){pk2(v[0], v[1]), pk2(v[2], v[3])}; }
            continue; } r -= I_GRP;
        { const int le = r / 768, q = r % 768, which = q / 256, ii = q % 256;
          if (which < 2) { const int n0 = 64 * (ii % 8), drow0 = 256 * (n0 / 128) + (n0 % 128) + (which ? 128 : 0);
              tr_item(a.in[which ? 22 : 21] + (size_t)le * D * FF, D, FF, (bf16*)(ws + WS_W13) + (size_t)le * 1024 * D, 64 * (ii / 8), n0, drow0, scr, F.lane); }
          else tr_item(a.in[23] + (size_t)le * FF * D, FF, D, (bf16*)(ws + WS_W2) + (size_t)le * D * FF, 64 * (ii / 32), 64 * (ii % 32), 64 * (ii % 32), scr, F.lane); }
    }
}
__device__ __forceinline__ void p0_router_frags(const Ctx& F, const Args& a) {
    typedef _Float16 f16x8 __attribute__((ext_vector_type(8)));
    GAS f16x8* out = (GAS f16x8*)(a.ws + WS_W16);
    for (int i = F.vcu * NTHR + F.tid; i < 2 * 128 * 2 * 64; i += F.G * NTHR) {
        const int lane = i & 63, nt = (i >> 6) & 1, ks = (i >> 7) & 127, layer = i >> 14, col = 32 * nt + (lane & 31), k0 = 16 * ks + 8 * (lane >> 5);
        f16x8 v;
#pragma unroll
        for (int j = 0; j < 8; ++j) { float x = 0.f; if (col < 32) x = a.in[19][((size_t)layer * D + k0 + j) * 32 + col]; else if (col < 36) x = a.in[17][((size_t)layer * D + k0 + j) * 4 + (col - 32)]; v[j] = (_Float16)x; }
        out[i] = v;
    }
}
__device__ __forceinline__ void p0_mod(const Ctx& F, const Args& a, int u_lo, int u_hi, int me, int nb, bool with_lb, unsigned* queue = nullptr) {
    float* sm = (float*)(a.ws + WS_SMALL);
    LAS float* sv = (LAS float*)F.lds;
    LAS float* part = sv + 3 * D;
    for (int k = F.tid; k < D; k += NTHR) { sv[k] = silu_f(a.in[1][k]); sv[D + k] = silu_f(a.in[1][D + k]); sv[2 * D + k] = silu_f(a.in[3][k]); }
    __syncthreads();
    if (me < 0 || me >= nb) return;
    LAS int* qslot = (LAS int*)(part + 32 * 192);
    for (int u = u_lo + me; ; u += nb) {
        if (queue) { __syncthreads(); if (F.tid == 0) *qslot = (int)__hip_atomic_fetch_add(queue, 1u, __ATOMIC_RELAXED, __HIP_MEMORY_SCOPE_AGENT); __syncthreads(); u = u_lo + *qslot; }
        if (u >= u_hi) break;
        const int l = u / 192, col0 = (u % 192) * 64;
        const int sub = F.lane >> 4, q = F.lane & 15, slot = F.wave * 4 + sub;
        f32x4 a0 = {0.f, 0.f, 0.f, 0.f}, a1 = a0, a2 = a0;
        { const float* w = a.in[4] + (size_t)l * D * 6 * D + col0 + 4 * q;
#pragma unroll 8
            for (int r = slot; r < D; r += 32) { const f32x4 v = *(const GAS f32x4*)(w + (size_t)r * 6 * D); a0 += v * sv[r]; a1 += v * sv[D + r]; a2 += v * sv[2 * D + r]; }
            LAS float* p = part + slot * 192 + 4 * q;
            *(LAS f32x4*)p = a0; *(LAS f32x4*)(p + 64) = a1; *(LAS f32x4*)(p + 128) = a2;
        }
        __syncthreads();
        if (F.tid < 192) { float s = 0.f;
#pragma unroll
            for (int i = 0; i < 32; ++i) s += part[i * 192 + F.tid];
            const int v = F.tid >> 6, j = col0 + (F.tid & 63); s += a.in[5][l * 6 * D + j];
            if (v < 2) sm[SM_MOD + (l * 2 + v) * 6 * D + j] = s; else if (l == 0) sm[SM_MC + j] = s; }
        __syncthreads();
    }
    if (with_lb) for (int i = me * NTHR + F.tid; i < 2048; i += nb * NTHR) {
        const int dir = i >> 10, k = i & 1023; const float* hl = a.in[10];
        const float x0 = hl[(dir * 3 + 0) * 1024 + k], x1 = hl[(dir * 3 + 1) * 1024 + k], x2 = hl[(dir * 3 + 2) * 1024 + k];
        const float m = fmaxf(x0, fmaxf(x1, x2)), e0 = expf(x0 - m), e1 = expf(x1 - m), e2 = expf(x2 - m);
        sm[SM_LB + i] = e0 / (e0 + e1 + e2);
    }
}
__device__ __forceinline__ void p1_modulate(const Ctx& F, const Args& a) {
    const float* sm = (const float*)(a.ws + WS_SMALL); bf16* HX = (bf16*)(a.ws + WS_HX);
#pragma unroll 4
    for (int i = F.vcu * NTHR + F.tid; i < MROWS * (D / 8); i += F.G * NTHR) {
        const int t = i >> 8, d = (i & 255) * 8;
        const float* src; const float* sh; const float* sc;
        if (t < NTOK) { src = a.in[0] + (size_t)t * D + d; sh = sm + SM_MOD + (t / SEQ) * 6 * D + d; sc = sh + D; }
        else { src = a.in[2] + (size_t)(t - NTOK) * D + d; sh = sm + SM_MC + d; sc = sh + D; }
        const f32x4 x0 = *(const GAS f32x4*)src, x1 = *(const GAS f32x4*)(src + 4), h0 = *(const GAS f32x4*)sh, h1 = *(const GAS f32x4*)(sh + 4), c0 = *(const GAS f32x4*)sc, c1 = *(const GAS f32x4*)(sc + 4);
        const f32x4 y0 = x0 * (c0 + 1.f) + h0, y1 = x1 * (c1 + 1.f) + h1;
        v4u o; o.x = pk2(y0[0], y0[1]); o.y = pk2(y0[2], y0[3]); o.z = pk2(y1[0], y1[1]); o.w = pk2(y1[2], y1[3]);
        *(GAS v4u*)(HX + (size_t)t * D + d) = o;
    }
}
typedef short bf16x8_t __attribute__((ext_vector_type(8)));
typedef float f32x16 __attribute__((ext_vector_type(16)));
typedef unsigned short u16x4_t __attribute__((ext_vector_type(4)));
__device__ __forceinline__ unsigned offb(unsigned row, unsigned ch) { return 256u * row + 16u * (ch ^ (((row & 3u) << 2) | ((row >> 2) & 3u))); }
__device__ __forceinline__ unsigned cvtpk(float lo, float hi) { unsigned r; asm volatile("v_cvt_pk_bf16_f32 %0, %1, %2" : "=v"(r) : "v"(lo), "v"(hi)); return r; }
#define TR8(d0, d1, d2, d3, d4, d5, d6, d7, a0, a1, a2, a3, a4, a5, a6, a7, OFF) \
    asm volatile("ds_read_b64_tr_b16 %0, %8 offset:" #OFF "\n\tds_read_b64_tr_b16 %1, %9 offset:" #OFF "\n\tds_read_b64_tr_b16 %2, %10 offset:" #OFF "\n\tds_read_b64_tr_b16 %3, %11 offset:" #OFF "\n\t" \
                 "ds_read_b64_tr_b16 %4, %12 offset:" #OFF "\n\tds_read_b64_tr_b16 %5, %13 offset:" #OFF "\n\tds_read_b64_tr_b16 %6, %14 offset:" #OFF "\n\tds_read_b64_tr_b16 %7, %15 offset:" #OFF "\n\ts_waitcnt lgkmcnt(0)" \
                 : "=&v"(d0), "=&v"(d1), "=&v"(d2), "=&v"(d3), "=&v"(d4), "=&v"(d5), "=&v"(d6), "=&v"(d7) : "v"(a0), "v"(a1), "v"(a2), "v"(a3), "v"(a4), "v"(a5), "v"(a6), "v"(a7) : "memory")
__device__ __forceinline__ bf16x8_t cat4(u16x4_t lo, u16x4_t hi) { bf16x8_t r; r[0] = (short)lo[0]; r[1] = (short)lo[1]; r[2] = (short)lo[2]; r[3] = (short)lo[3]; r[4] = (short)hi[0]; r[5] = (short)hi[1]; r[6] = (short)hi[2]; r[7] = (short)hi[3]; return r; }

typedef short s16x4_t __attribute__((ext_vector_type(4)));
__device__ __forceinline__ bf16x8_t trd2(unsigned a0, unsigned a1) {
    const s16x4_t lo = __builtin_amdgcn_ds_read_tr16_b64_v4i16((LAS s16x4_t*)(size_t)a0), hi = __builtin_amdgcn_ds_read_tr16_b64_v4i16((LAS s16x4_t*)(size_t)a1);
    return __builtin_shufflevector(lo, hi, 0, 1, 2, 3, 4, 5, 6, 7);
}
__device__ __forceinline__ void p4_attn_mfma(const Ctx& F, const Args& a) {
    const bf16* P = (const bf16*)(a.ws + WS_REGA); const bf16* PC = P + (size_t)NTOK * MIXW; bf16* CAT = (bf16*)(a.ws + WS_CAT);
    LAS unsigned char* Kl = F.lds; LAS unsigned char* Vl = F.lds + 16384;
    const int w = F.wave, l = F.lane, qi = l & 31, h = l >> 5, tid = F.tid;
    constexpr float CS = 0.08838834764831845f * 1.4426950408889634f;
    unsigned ka[8];
#pragma unroll
    for (int ks = 0; ks < 8; ++ks) ka[ks] = offb(qi, 2 * ks + h);
    unsigned va[8];
    { const unsigned blk = (l >> 4) & 1, q4 = (l & 15) >> 2, p = l & 3;
#pragma unroll
      for (int c = 0; c < 4; ++c)
#pragma unroll
          for (int t = 0; t < 2; ++t) va[c * 2 + t] = (unsigned)(size_t)Vl + offb(8 * t + 4 * h + q4, 4 * c + 2 * blk + (p >> 1)) + 8 * (p & 1); }
    for (int u = F.vcu; u < 256; u += F.G) {
        const int kvh = u & 3, qb = (u >> 2) & 31, b = u >> 7;
        const int head = kvh * 2 + (w >> 2), q0 = qb * 128 + 32 * (w & 3);
        bf16x8_t Q[8];
        { const bf16* qrow = P + (size_t)(b * SEQ + q0 + qi) * MIXW + C_Q + head * 128 + 8 * h;
#pragma unroll
          for (int ks = 0; ks < 8; ++ks) Q[ks] = *(const GAS bf16x8_t*)(qrow + 16 * ks); }
        const float sink2 = a.in[9][head] * 1.4426950408889634f;
        float m = sink2, lsum = 1.f;
        f32x16 O[4];
#pragma unroll
        for (int c = 0; c < 4; ++c)
#pragma unroll
            for (int r = 0; r < 16; ++r) O[c][r] = 0.f;
        const int kt_lo = (2 * qb - 2 < 0) ? 0 : 2 * qb - 2, kt_hi = (2 * qb + 4 > 64) ? 64 : 2 * qb + 4, nlat = kt_hi - kt_lo, ntile = nlat + 4;
        v4u kr[2], vr[2];
        auto src_row = [&](int ti, int row) -> const bf16* { return (ti < nlat) ? (P + (size_t)(b * SEQ + (kt_lo + ti) * 64 + row) * MIXW) : (PC + (size_t)(b * CTXL + (ti - nlat) * 64 + row) * MIXW); };
#pragma unroll
        for (int i = 0; i < 2; ++i) { const int n = tid + 512 * i; const bf16* r0 = src_row(0, n >> 4) + kvh * 128 + 8 * (n & 15); kr[i] = *(const GAS v4u*)(r0 + C_K); vr[i] = *(const GAS v4u*)(r0 + C_V); }
        for (int ti = 0; ti < ntile; ++ti) {
            __syncthreads();
#pragma unroll
            for (int i = 0; i < 2; ++i) { const int n = tid + 512 * i; const unsigned o = offb(n >> 4, n & 15); *(LAS v4u*)(Kl + o) = kr[i]; *(LAS v4u*)(Vl + o) = vr[i]; }
            __syncthreads();
            if (ti + 1 < ntile) {
#pragma unroll
                for (int i = 0; i < 2; ++i) { const int n = tid + 512 * i; const bf16* r0 = src_row(ti + 1, n >> 4) + kvh * 128 + 8 * (n & 15); kr[i] = *(const GAS v4u*)(r0 + C_K); vr[i] = *(const GAS v4u*)(r0 + C_V); }
            }
            f32x16 S0, S1;
#pragma unroll
            for (int r = 0; r < 16; ++r) { S0[r] = 0.f; S1[r] = 0.f; }
#pragma unroll
            for (int ks = 0; ks < 8; ++ks) {
                const bf16x8_t a0 = *(const LAS bf16x8_t*)(Kl + ka[ks]), a1 = *(const LAS bf16x8_t*)(Kl + ka[ks] + 8192);
                S0 = __builtin_amdgcn_mfma_f32_32x32x16_bf16(a0, Q[ks], S0, 0, 0, 0);
                S1 = __builtin_amdgcn_mfma_f32_32x32x16_bf16(a1, Q[ks], S1, 0, 0, 0);
            }
            const bool lat = ti < nlat && (kt_lo + ti < 2 * qb || kt_lo + ti > 2 * qb + 1);     const int dbase = (q0 + qi) - ((kt_lo + ti) * 64 + 4 * h);
            float mx = -INFINITY;
#pragma unroll
            for (int r = 0; r < 16; ++r) {
                float t0 = S0[r] * CS, t1 = S1[r] * CS;
                if (lat) { const int d0 = dbase - ((r & 3) + 8 * (r >> 2)), d1 = d0 - 32; if ((unsigned)(d0 + 128) > 256u) t0 = -INFINITY; if ((unsigned)(d1 + 128) > 256u) t1 = -INFINITY; }
                S0[r] = t0; S1[r] = t1; mx = fmaxf(mx, fmaxf(t0, t1));
            }
            mx = fmaxf(mx, __shfl_xor(mx, 32));
            const float mn = fmaxf(m, mx), alpha = __builtin_amdgcn_exp2f(m - mn);
            float rs = 0.f;
#pragma unroll
            for (int r = 0; r < 16; ++r) { S0[r] = __builtin_amdgcn_exp2f(S0[r] - mn); S1[r] = __builtin_amdgcn_exp2f(S1[r] - mn); rs += S0[r] + S1[r]; }
            rs += __shfl_xor(rs, 32);
            lsum = lsum * alpha + rs; m = mn;
#pragma unroll
            for (int c = 0; c < 4; ++c)
#pragma unroll
                for (int r = 0; r < 16; ++r) O[c][r] *= alpha;
            bf16x8_t Pf[4];
#pragma unroll
            for (int s = 0; s < 2; ++s) {
                union { bf16x8_t v; unsigned u[4]; } x0, x1;
#pragma unroll
                for (int j = 0; j < 4; ++j) { x0.u[j] = cvtpk(S0[8 * s + 2 * j], S0[8 * s + 2 * j + 1]); x1.u[j] = cvtpk(S1[8 * s + 2 * j], S1[8 * s + 2 * j + 1]); }
                Pf[s] = x0.v; Pf[2 + s] = x1.v;
            }
#define ATT_PV(KK, OFF) do { \
                O[0] = __builtin_amdgcn_mfma_f32_32x32x16_bf16(trd2(va[0] + (OFF), va[1] + (OFF)), Pf[KK], O[0], 0, 0, 0); O[1] = __builtin_amdgcn_mfma_f32_32x32x16_bf16(trd2(va[2] + (OFF), va[3] + (OFF)), Pf[KK], O[1], 0, 0, 0); \
                O[2] = __builtin_amdgcn_mfma_f32_32x32x16_bf16(trd2(va[4] + (OFF), va[5] + (OFF)), Pf[KK], O[2], 0, 0, 0); O[3] = __builtin_amdgcn_mfma_f32_32x32x16_bf16(trd2(va[6] + (OFF), va[7] + (OFF)), Pf[KK], O[3], 0, 0, 0); } while (0)
            ATT_PV(0, 0); ATT_PV(1, 4096); ATT_PV(2, 8192); ATT_PV(3, 12288);
#undef ATT_PV
        }
        const float inv = 1.f / lsum;
        bf16* orow = CAT + (size_t)(b * SEQ + q0 + qi) * D + head * 128 + 4 * h;
#pragma unroll
        for (int c = 0; c < 4; ++c)
#pragma unroll
            for (int rr = 0; rr < 4; ++rr)
                *(GAS v2u*)(orow + 32 * c + 8 * rr) = (v2u){cvtpk(O[c][4 * rr] * inv, O[c][4 * rr + 1] * inv), cvtpk(O[c][4 * rr + 2] * inv, O[c][4 * rr + 3] * inv)};
    }
}
constexpr int HG_QP = 0, HG_KP = 16384, HG_VV = 32768, HG_SC = 49152, HG_EM = 58368, HG_EE = 58880, HG_T0 = 59392, HG_DIR = 61440;
constexpr size_t HG_LSZ = (size_t)128 * 128;
constexpr size_t WS_HGL = WS_X1, WS_HGG = WS_X1 + (size_t)2 * 16 * 17 * HG_LSZ * 4, WS_HGS = WS_YX;
static_assert(WS_HGG + (size_t)2 * 16 * 17 * 256 * 4 <= WS_X2 && (size_t)2 * 16 * 16 * HG_LSZ * 4 <= (size_t)NTOK * D * 4, "hgrn workspace");
#define TR2(d0, d1, a0, a1, OFF) asm volatile("ds_read_b64_tr_b16 %0, %2 offset:" #OFF "\n\tds_read_b64_tr_b16 %1, %3 offset:" #OFF "\n\ts_waitcnt lgkmcnt(0)" : "=&v"(d0), "=&v"(d1) : "v"(a0), "v"(a1) : "memory")

template <bool OUT> __device__ __forceinline__ void hg_unit(const Ctx& F, const Args& a, int b, int hh, int chunk  ) {
    const bf16* P = (const bf16*)(a.ws + WS_REGA); const float* sm = (const float*)(a.ws + WS_SMALL);
    const int dir = F.wave >> 2, wd = F.wave & 3, l = F.lane, qi = l & 31, h = l >> 5, tt = F.tid & 255, kch = tt & 127, half = tt >> 7;
    LAS unsigned char* Ld = F.lds + dir * HG_DIR;
    const GAS bf16* rows = (const GAS bf16*)((chunk < 16) ? (P + (size_t)(b * SEQ + chunk * 256) * MIXW) : (P + (size_t)(NTOK + b * CTXL) * MIXW));
    const int chain = b * 8 + hh;
    const float lbk = ((const GAS float*)sm)[SM_LB + dir * 1024 + hh * 128 + kch];
    f32x16 S[4];
    if (OUT) { const GAS float* s0 = (const GAS float*)(a.ws + WS_HGS) + ((size_t)(dir * 16 + chain) * 16 + chunk) * HG_LSZ + 32 * wd + qi;
#pragma unroll
        for (int kt = 0; kt < 4; ++kt)
#pragma unroll
            for (int r = 0; r < 16; ++r) S[kt][r] = s0[(size_t)(32 * kt + (r & 3) + 8 * (r >> 2) + 4 * h) * 128]; }
    else {
#pragma unroll
        for (int kt = 0; kt < 4; ++kt)
#pragma unroll
            for (int r = 0; r < 16; ++r) S[kt][r] = 0.f; }
    float gtot = 0.f;
    unsigned vta[2], kta[8];
    { const unsigned blk = (l >> 4) & 1, q4 = (l & 15) >> 2, p = l & 3;
#pragma unroll
      for (int t = 0; t < 2; ++t) { vta[t] = (unsigned)(size_t)(Ld + HG_VV) + offb(8 * h + 4 * t + q4, 4 * wd + 2 * blk + (p >> 1)) + 8 * (p & 1);
#pragma unroll
          for (int kt = 0; kt < 4; ++kt) kta[kt * 2 + t] = (unsigned)(size_t)(Ld + HG_KP) + offb(8 * h + 4 * t + q4, 4 * kt + 2 * blk + (p >> 1)) + 8 * (p & 1); } }
    v4u rk[4], rv[4], rq[4];
#pragma unroll
    for (int i = 0; i < 4; ++i) { const int n = tt + 256 * i, t = n >> 4, ch = n & 15, tok = dir ? 255 - t : t;
        const GAS bf16* rp = rows + (size_t)tok * MIXW + hh * 128 + 8 * ch;
        rk[i] = *(const GAS v4u*)(rp + (dir ? C_FB : C_FF)); rv[i] = *(const GAS v4u*)(rp + C_HI); if (OUT) rq[i] = *(const GAS v4u*)(rp + C_HQ); else rq[i] = rk[i]; }
#pragma unroll 1
    for (int sub = 0; sub < 4; ++sub) {
#pragma unroll
        for (int i = 0; i < 4; ++i) { const int n = tt + 256 * i, t = n >> 4, ch = n & 15; const unsigned o = offb(t, ch);
            *(LAS v4u*)(Ld + HG_KP + o) = rk[i]; *(LAS v4u*)(Ld + HG_VV + o) = rv[i]; if (OUT) *(LAS v4u*)(Ld + HG_QP + o) = rq[i]; }
        __syncthreads();
        if (sub < 3) {
#pragma unroll
            for (int i = 0; i < 4; ++i) { const int n = tt + 256 * i, t = n >> 4, ch = n & 15, p = 64 * (sub + 1) + t, tok = dir ? 255 - p : p;
                const GAS bf16* rp = rows + (size_t)tok * MIXW + hh * 128 + 8 * ch;
                rk[i] = *(const GAS v4u*)(rp + (dir ? C_FB : C_FF)); rv[i] = *(const GAS v4u*)(rp + C_HI); if (OUT) rq[i] = *(const GAS v4u*)(rp + C_HQ); }
        }
        { float prod = 1.f;
#pragma unroll 8
          for (int ii = 0; ii < 32; ++ii) { const int i = half ? ii : 31 - ii, t = 32 * half + i;
              const unsigned o = offb(t, kch >> 3) + 2 * (kch & 7);
              const float xl = bf2f(*(const LAS unsigned short*)(Ld + HG_KP + o)); const float f = lbk + (1.f - lbk) * fsigmoid(xl);
              float up, dn;
              if (half) { prod *= f; up = prod; dn = __builtin_amdgcn_rcpf(prod); } else { dn = prod; up = __builtin_amdgcn_rcpf(prod); prod *= f; }
              *(LAS unsigned short*)(Ld + HG_KP + o) = (unsigned short)f2bf((1.f - f) * dn);
              if (OUT) { const float q = bf2f(*(const LAS unsigned short*)(Ld + HG_QP + o)); *(LAS unsigned short*)(Ld + HG_QP + o) = (unsigned short)f2bf(q * up); } }
          *(LAS float*)(Ld + (half ? HG_EE : HG_EM) + 4 * kch) = prod; gtot += __logf(prod); }
        __syncthreads();
        if (OUT) {
            const int mt = wd >> 1, nt = wd & 1;
            f32x16 C;
#pragma unroll
            for (int r = 0; r < 16; ++r) C[r] = 0.f;
            if (!(mt == 0 && nt == 1)) {
#pragma unroll
                for (int ks = 0; ks < 8; ++ks) { const bf16x8_t af = *(const LAS bf16x8_t*)(Ld + HG_QP + offb(32 * mt + qi, 2 * ks + h)), bfv = *(const LAS bf16x8_t*)(Ld + HG_KP + offb(32 * nt + qi, 2 * ks + h));
                    C = __builtin_amdgcn_mfma_f32_32x32x16_bf16(af, bfv, C, 0, 0, 0); } }
            const int s = 32 * nt + qi;
#pragma unroll
            for (int r = 0; r < 16; ++r) { const int t = 32 * mt + (r & 3) + 8 * (r >> 2) + 4 * h; const float v = (s <= t) ? C[r] : 0.f;
                *(LAS unsigned short*)(Ld + HG_SC + t * 144 + 2 * s) = (unsigned short)f2bf(v); }
        }
#pragma unroll
        for (int kt = 0; kt < 4; ++kt)
#pragma unroll
            for (int rr = 0; rr < 4; ++rr) { const f32x4 e4 = *(const LAS f32x4*)(Ld + HG_EM + 4 * (32 * kt + 8 * rr + 4 * h));
#pragma unroll
                for (int j = 0; j < 4; ++j) S[kt][4 * rr + j] *= e4[j]; }
        if (OUT) __syncthreads();
        bf16x8_t Vf[4];
        Vf[0] = trd2(vta[0], vta[1]); Vf[1] = trd2(vta[0] + 4096, vta[1] + 4096); Vf[2] = trd2(vta[0] + 8192, vta[1] + 8192); Vf[3] = trd2(vta[0] + 12288, vta[1] + 12288);
        if (OUT) {
            f32x16 o0, o1;
#pragma unroll
            for (int r = 0; r < 16; ++r) { o0[r] = 0.f; o1[r] = 0.f; }
#pragma unroll
            for (int kt = 0; kt < 4; ++kt)
#pragma unroll
                for (int s2 = 0; s2 < 2; ++s2) {
                    union { bf16x8_t v; unsigned u[4]; } sb;
#pragma unroll
                    for (int j = 0; j < 4; ++j) sb.u[j] = cvtpk(S[kt][8 * s2 + 2 * j], S[kt][8 * s2 + 2 * j + 1]);
                    union { bf16x8_t v; v2u p[2]; } q0, q1;
                    q0.p[0] = *(const LAS v2u*)(Ld + HG_QP + offb(qi, 4 * kt + 2 * s2) + 8 * h); q0.p[1] = *(const LAS v2u*)(Ld + HG_QP + offb(qi, 4 * kt + 2 * s2 + 1) + 8 * h);
                    q1.p[0] = *(const LAS v2u*)(Ld + HG_QP + offb(32 + qi, 4 * kt + 2 * s2) + 8 * h); q1.p[1] = *(const LAS v2u*)(Ld + HG_QP + offb(32 + qi, 4 * kt + 2 * s2 + 1) + 8 * h);
                    o0 = __builtin_amdgcn_mfma_f32_32x32x16_bf16(q0.v, sb.v, o0, 0, 0, 0); o1 = __builtin_amdgcn_mfma_f32_32x32x16_bf16(q1.v, sb.v, o1, 0, 0, 0);
                }
#pragma unroll
            for (int ss = 0; ss < 4; ++ss) { const bf16x8_t a0 = *(const LAS bf16x8_t*)(Ld + HG_SC + qi * 144 + 32 * ss + 16 * h), a1 = *(const LAS bf16x8_t*)(Ld + HG_SC + (32 + qi) * 144 + 32 * ss + 16 * h);
                o0 = __builtin_amdgcn_mfma_f32_32x32x16_bf16(a0, Vf[ss], o0, 0, 0, 0); o1 = __builtin_amdgcn_mfma_f32_32x32x16_bf16(a1, Vf[ss], o1, 0, 0, 0); }
            GAS float* O = (GAS float*)(a.ws + WS_REGB) + (size_t)dir * NTOK * 1024 + (size_t)(b * SEQ + chunk * 256) * 1024 + hh * 128 + 32 * wd + qi;
#pragma unroll
            for (int r = 0; r < 16; ++r) { const int t = (r & 3) + 8 * (r >> 2) + 4 * h, p0 = 64 * sub + t, p1 = p0 + 32;
                O[(size_t)(dir ? 255 - p0 : p0) * 1024] = o0[r]; O[(size_t)(dir ? 255 - p1 : p1) * 1024] = o1[r]; }
        }
#define HG_UPD(SS, OFF) do { _Pragma("unroll") for (int kt = 0; kt < 4; ++kt) \
            S[kt] = __builtin_amdgcn_mfma_f32_32x32x16_bf16(trd2(kta[kt * 2] + (OFF), kta[kt * 2 + 1] + (OFF)), Vf[SS], S[kt], 0, 0, 0); } while (0)
        HG_UPD(0, 0); HG_UPD(1, 4096); HG_UPD(2, 8192); HG_UPD(3, 12288);
#undef HG_UPD
#pragma unroll
        for (int kt = 0; kt < 4; ++kt)
#pragma unroll
            for (int rr = 0; rr < 4; ++rr) { const f32x4 e4 = *(const LAS f32x4*)(Ld + HG_EE + 4 * (32 * kt + 8 * rr + 4 * h));
#pragma unroll
                for (int j = 0; j < 4; ++j) S[kt][4 * rr + j] *= e4[j]; }
        __syncthreads();
    }
    if (!OUT) {
        GAS float* Lp = (GAS float*)(a.ws + WS_HGL) + ((size_t)(dir * 16 + chain) * 17 + chunk) * HG_LSZ + 32 * wd + qi;
#pragma unroll
        for (int kt = 0; kt < 4; ++kt)
#pragma unroll
            for (int r = 0; r < 16; ++r) Lp[(size_t)(32 * kt + (r & 3) + 8 * (r >> 2) + 4 * h) * 128] = S[kt][r];
        ((float*)(a.ws + WS_HGG))[(((size_t)(dir * 16 + chain) * 17 + chunk) * 2 + half) * 128 + kch] = gtot;
    }
}
__device__ __forceinline__ void p_hg_summaries(const Ctx& F, const Args& a) {
    for (int u = F.vcu; u < 256; u += F.G) hg_unit<false>(F, a, (u >> 4) >> 3, (u >> 4) & 7, u & 15);
}
__device__ __forceinline__ void p_hg_ctx_summaries(const Ctx& F, const Args& a, int first, int nblk) {
    for (int u = F.vcu - first; u >= 0 && u < 16; u += nblk) hg_unit<false>(F, a, u >> 3, u & 7, 16);
}
__device__ __forceinline__ void p_hg_carry(const Ctx& F, const Args& a) {
    const float* Lb = (const float*)(a.ws + WS_HGL); const float* Gb = (const float*)(a.ws + WS_HGG); float* Sb = (float*)(a.ws + WS_HGS);
    for (int i = F.vcu * NTHR + F.tid; i < 32 * 4096; i += F.G * NTHR) {
        const int dc = i >> 12, e4 = (i & 4095) * 4, k = e4 >> 7, dir = dc >> 4;
        const float* Lc = Lb + (size_t)dc * 17 * HG_LSZ + e4; const float* Gc = Gb + (size_t)dc * 17 * 256 + k; float* Sc = Sb + (size_t)dc * 16 * HG_LSZ + e4;
        f32x4 s = *(const GAS f32x4*)(Lc + 16 * HG_LSZ);
#pragma unroll
        for (int j = 0; j < 16; ++j) { const int c = dir ? 15 - j : j;
            *(GAS f32x4*)(Sc + (size_t)c * HG_LSZ) = s;
            s = s * __expf(Gc[c * 256] + Gc[c * 256 + 128]) + *(const GAS f32x4*)(Lc + (size_t)c * HG_LSZ); }
    }
}
__device__ __forceinline__ void hg_norm_unit(const Ctx& F, const Args& a, int b, int hh, int chunk) {
    const bf16* P = (const bf16*)(a.ws + WS_REGA); bf16* CAT = (bf16*)(a.ws + WS_CAT); const float* gain = a.in[11];
    const __amdgpu_buffer_rsrc_t ors = __builtin_amdgcn_make_buffer_rsrc((void*)(a.ws + WS_REGB), 0, 0x7fffffff, 0x00020000);
    int tz = threadIdx.x; asm volatile("" : "+v"(tz));
    const int lane = tz & 63, wv = __builtin_amdgcn_readfirstlane(tz >> 6); const f32x2v gn = *(const GAS f32x2v*)(gain + hh * 128 + 2 * lane);
    for (int r0 = wv * 16; r0 < 256; r0 += NWAVES * 16) {
        float a0[16], a1[16]; unsigned gw[16];
#pragma unroll
        for (int u = 0; u < 16; ++u) { const int t = b * SEQ + chunk * 256 + r0 + u; const unsigned off = (unsigned)(((size_t)t * 1024 + hh * 128 + 2 * lane) * 4);
            const f32x2v f = __builtin_bit_cast(f32x2v, __builtin_amdgcn_raw_buffer_load_b64(ors, (int)off, 0, 0)), bq = __builtin_bit_cast(f32x2v, __builtin_amdgcn_raw_buffer_load_b64(ors, (int)(off + (unsigned)NTOK * 1024u * 4u), 0, 0));
            a0[u] = f[0] + bq[0]; a1[u] = f[1] + bq[1];
            gw[u] = *(const GAS unsigned*)(P + (size_t)t * MIXW + C_HG + hh * 128 + 2 * lane); }
#pragma unroll
        for (int u = 0; u < 16; ++u) { const int t = b * SEQ + chunk * 256 + r0 + u;
            const float r = rsqrtf(wave_sum(a0[u] * a0[u] + a1[u] * a1[u]) * (1.f / 128.f) + NORM_EPS);
            *(GAS unsigned*)(CAT + (size_t)t * D + 1024 + hh * 128 + 2 * lane) = pk2(a0[u] * r * gn[0] * bflo(gw[u]), a1[u] * r * gn[1] * bfhi(gw[u]));   }
    }
}
__device__ __forceinline__ void p_hg_outputs(const Ctx& F, const Args& a) {
    for (int u = F.vcu; u < 256; u += F.G) { const int b = (u >> 4) >> 3, hh = (u >> 4) & 7, chunk = u & 15;
        hg_unit<true>(F, a, b, hh, chunk);
        asm volatile("s_waitcnt vmcnt(0)" ::: "memory"); __syncthreads();
        hg_norm_unit(F, a, b, hh, chunk); }
}
typedef _Float16 f16x8 __attribute__((ext_vector_type(8)));
typedef _Float16 f16x4 __attribute__((ext_vector_type(4)));
__device__ __forceinline__ void route_row(const LAS float* lgv, const float* brg, const float* bre, LAS unsigned* cnt, int* smi, int row) {
    float gl[4]; int gi = 0;
#pragma unroll
    for (int i = 0; i < 4; ++i) gl[i] = lgv[32 + i] + brg[i];
    float gm = gl[0];
#pragma unroll
    for (int i = 1; i < 4; ++i) if (gl[i] > gm) { gm = gl[i]; gi = i; }
    float gz = 0.f;
#pragma unroll
    for (int i = 0; i < 4; ++i) gz += expf(gl[i] - gm);
    const float gval = 1.f / gz;
    float el[8];
#pragma unroll
    for (int j = 0; j < 8; ++j) el[j] = lgv[gi * 8 + j] + bre[gi * 8 + j];
    int i1 = 0; float m1 = el[0];
#pragma unroll
    for (int j = 1; j < 8; ++j) if (el[j] > m1) { m1 = el[j]; i1 = j; }
    int i2 = 0; float m2 = -INFINITY;
#pragma unroll
    for (int j = 0; j < 8; ++j) if (j != i1 && el[j] > m2) { m2 = el[j]; i2 = j; }
    const float p2 = expf(m2 - m1), ga = gval / (1.f + p2), gb = gval * p2 / (1.f + p2);
    const int e1 = gi * 8 + i1, e2 = gi * 8 + i2;
    const int r1 = (int)__hip_atomic_fetch_add(cnt + e1, 1u, __ATOMIC_RELAXED, __HIP_MEMORY_SCOPE_WORKGROUP), r2 = (int)__hip_atomic_fetch_add(cnt + e2, 1u, __ATOMIC_RELAXED, __HIP_MEMORY_SCOPE_WORKGROUP);
    smi[SM_TOKE + 2 * row] = e1; smi[SM_TOKE + 2 * row + 1] = e2; smi[SM_TOKR + 2 * row] = r1; smi[SM_TOKR + 2 * row + 1] = r2;
    ((float*)smi)[SM_TOKG + 2 * row] = ga; ((float*)smi)[SM_TOKG + 2 * row + 1] = gb;
}
template <bool XB>
__device__ __forceinline__ void p_ln_router(const Ctx& F, const Args& a, int layer, const void* xres_, const bf16* Y, bf16* X1, bf16* TOK) {
    const float* xres = (const float*)xres_; const bf16* xrb = (const bf16*)xres_;
    const float* sm = (const float*)(a.ws + WS_SMALL); int* smi = (int*)(a.ws + WS_SMALL);
    const float* lg = a.in[6] + (layer * 2 + 0) * D; const float* lbias = a.in[7] + (layer * 2 + 0) * D;
    const float* brg = a.in[18] + layer * 4; const float* bre = a.in[20] + layer * 32;
    const GAS f16x8* wfr = (const GAS f16x8*)(a.ws + WS_W16) + (size_t)layer * 128 * 2 * 64;
    const int w = F.wave, l = F.lane;
    LAS unsigned char* timg = F.lds;
    LAS float* part = (LAS float*)F.lds;
    LAS float* lgt = (LAS float*)(F.lds + 40960);
    LAS unsigned* lcnt = (LAS unsigned*)(F.lds + 152064);
    if (F.tid < 32) lcnt[F.tid] = 0u;
    for (int grp = F.vcu; grp < NTOK / 32; grp += F.G) {
        __syncthreads();
#pragma unroll 1
        for (int r4 = 0; r4 < 4; ++r4) {
            const int rl = 4 * w + r4, row = grp * 32 + rl, b = row / SEQ; const float* mod = sm + SM_MOD + (layer * 2 + b) * 6 * D;
            f32x4 v[8]; float s = 0.f;
#pragma unroll
            for (int j = 0; j < 8; ++j) { const int d = 4 * l + 256 * j; f32x4 xv; if constexpr (XB) { const v2u xw = *(const GAS v2u*)(xrb + (size_t)row * D + d); xv = (f32x4){bflo(xw.x), bfhi(xw.x), bflo(xw.y), bfhi(xw.y)}; } else xv = *(const GAS f32x4*)(xres + (size_t)row * D + d);
                const f32x4 gv = *(const GAS f32x4*)(mod + 2 * D + d); const v2u yw = *(const GAS v2u*)(Y + (size_t)row * D + d);
                const f32x4 yv = (f32x4){bflo(yw.x), bfhi(yw.x), bflo(yw.y), bfhi(yw.y)};
                v[j] = xv * ALPHA + gv * yv; s += (v[j][0] + v[j][1]) + (v[j][2] + v[j][3]); }
            const float mean = wave_sum(s) * (1.f / D); float q = 0.f;
#pragma unroll
            for (int j = 0; j < 8; ++j) { v[j] = v[j] - mean; q += (v[j][0] * v[j][0] + v[j][1] * v[j][1]) + (v[j][2] * v[j][2] + v[j][3] * v[j][3]); }
            const float rstd = rsqrtf(wave_sum(q) * (1.f / D) + LN_EPS);
#pragma unroll
            for (int j = 0; j < 8; ++j) { const int d = 4 * l + 256 * j; const f32x4 o = v[j] * rstd * *(const GAS f32x4*)(lg + d) + *(const GAS f32x4*)(lbias + d);
                *(GAS v2u*)(X1 + (size_t)row * D + d) = (v2u){pk2(o[0], o[1]), pk2(o[2], o[3])};
                const f32x4 t4 = o * (*(const GAS f32x4*)(mod + 4 * D + d) + 1.f) + *(const GAS f32x4*)(mod + 3 * D + d);
                *(GAS v2u*)(TOK + (size_t)row * D + d) = (v2u){pk2(t4[0], t4[1]), pk2(t4[2], t4[3])};
                *(LAS f16x4*)(timg + rl * 4096 + 16 * ((d >> 3) ^ (rl & 15)) + 2 * (d & 7)) = (f16x4){(_Float16)t4[0], (_Float16)t4[1], (_Float16)t4[2], (_Float16)t4[3]}; }
        }
        __syncthreads();
        f32x16 c0, c1;
#pragma unroll
        for (int r = 0; r < 16; ++r) { c0[r] = 0.f; c1[r] = 0.f; }
        { const int ar = l & 31, ah = l >> 5;
#pragma unroll 4
          for (int ks = 0; ks < 16; ++ks) { const int ksg = 16 * w + ks;
              const f16x8 af = *(const LAS f16x8*)(timg + ar * 4096 + 16 * ((2 * ksg + ah) ^ (ar & 15)));
              const f16x8 b0 = wfr[(size_t)(ksg * 2 + 0) * 64 + l], b1 = wfr[(size_t)(ksg * 2 + 1) * 64 + l];
              c0 = __builtin_amdgcn_mfma_f32_32x32x16_f16(af, b0, c0, 0, 0, 0); c1 = __builtin_amdgcn_mfma_f32_32x32x16_f16(af, b1, c1, 0, 0, 0); } }
        __syncthreads();
        { const int col = l & 31, ah = l >> 5;
#pragma unroll
          for (int r = 0; r < 16; ++r) { const int row = (r & 3) + 8 * (r >> 2) + 4 * ah; part[(w * 32 + row) * 36 + col] = c0[r]; if (col < 4) part[(w * 32 + row) * 36 + 32 + col] = c1[r]; } }
        __syncthreads();
        for (int i = F.tid; i < 32 * 36; i += NTHR) { float sacc = 0.f;
#pragma unroll
            for (int ww = 0; ww < 8; ++ww) sacc += part[ww * 32 * 36 + i];
            lgt[i] = sacc; }
        __syncthreads();
        if (F.tid < 32) route_row(lgt + F.tid * 36, brg, bre, lcnt, smi, grp * 32 + F.tid);
    }
    __syncthreads();
    if (F.tid < 32) smi[SM_BCNT + (layer * 256 + F.vcu) * 32 + F.tid] = (int)lcnt[F.tid];
}
__device__ __forceinline__ void moe_table(const Ctx& F, const Args& a, int layer, bool bases) {
    const int* bc = (const int*)(a.ws + WS_SMALL) + SM_BCNT + layer * 256 * 32;
    LAS int* tab = (LAS int*)(F.lds + LDS_TAB); LAS int* part = (LAS int*)F.lds; LAS int* bb = part + 512;
    const int e = F.tid & 31, seg = F.tid >> 5;
    int sum = 0;
    for (int i = 0; i < 16; ++i) { const int wg = seg * 16 + i; if (wg < F.G) sum += bc[wg * 32 + e]; }
    part[seg * 32 + e] = sum;
    __syncthreads();
    int pre = 0, tot = 0;
    for (int s = 0; s < 16; ++s) { const int v = part[s * 32 + e]; if (s < seg) pre += v; tot += v; }
    if (seg == 0) tab[e] = (tot + 255) >> 8;
    if (bases) { int run = pre; for (int i = 0; i < 16; ++i) { const int wg = seg * 16 + i; if (wg < F.G) { bb[e * 256 + wg] = run; run += bc[wg * 32 + e]; } } }
    __syncthreads();
}
__device__ __forceinline__ void p_gather(const Ctx& F, const Args& a, int layer) {
    moe_table(F, a, layer, true);
    const LAS int* tab = (const LAS int*)(F.lds + LDS_TAB); const LAS int* bb = (const LAS int*)F.lds + 512; int* smi = (int*)(a.ws + WS_SMALL);
    for (int as = F.vcu * NTHR + F.tid; as < 2 * NTOK; as += F.G * NTHR) {
        const int e = smi[SM_TOKE + as], r = smi[SM_TOKR + as], wg = ((as >> 1) >> 5) % F.G; int pre = 0;
        for (int i = 0; i < e; ++i) pre += tab[i];
        const int slot = 256 * pre + bb[e * 256 + wg] + r;
        smi[SM_TOKS + as] = slot; smi[SM_SLOTTOK + slot] = as >> 1;
    }
}
template <bool OB>
__device__ __forceinline__ void p_ln2(const Ctx& F, const Args& a, int layer, void* XO_, bf16* HXN) {
    float* XO = (float*)XO_; bf16* XOB = (bf16*)XO_;
    const float* sm = (const float*)(a.ws + WS_SMALL); const int* smi = (const int*)(a.ws + WS_SMALL);
    const bf16* X1 = (const bf16*)(a.ws + WS_X1); const bf16* YS = (const bf16*)(a.ws + WS_REGB);
    const float* lg = a.in[6] + (layer * 2 + 1) * D; const float* lbias = a.in[7] + (layer * 2 + 1) * D;
    const int l = F.lane;
    for (int row0 = F.vcu * NWAVES + F.wave; row0 < NTOK; row0 += 2 * F.G * NWAVES) {
        f32x4 v[2][8]; float mean[2], rstd[2]; int rows[2]; bool ok[2];
#pragma unroll
        for (int u = 0; u < 2; ++u) { const int row = row0 + u * F.G * NWAVES; ok[u] = row < NTOK; rows[u] = ok[u] ? row : row0;
            const int r = rows[u], b = r / SEQ; const float* mod = sm + SM_MOD + (layer * 2 + b) * 6 * D;
            const int s0 = smi[SM_TOKS + 2 * r], s1 = smi[SM_TOKS + 2 * r + 1]; const float g0 = sm[SM_TOKG + 2 * r], g1 = sm[SM_TOKG + 2 * r + 1];
#pragma unroll
            for (int j = 0; j < 8; ++j) { const int d = 4 * l + 256 * j; const v2u xw = *(const GAS v2u*)(X1 + (size_t)r * D + d); const f32x4 xv = (f32x4){bflo(xw.x), bfhi(xw.x), bflo(xw.y), bfhi(xw.y)}, gv = *(const GAS f32x4*)(mod + 5 * D + d);
                const v2u y0 = *(const GAS v2u*)(YS + (size_t)s0 * D + d), y1 = *(const GAS v2u*)(YS + (size_t)s1 * D + d);
                const f32x4 yv = (f32x4){bflo(y0.x), bfhi(y0.x), bflo(y0.y), bfhi(y0.y)} * g0 + (f32x4){bflo(y1.x), bfhi(y1.x), bflo(y1.y), bfhi(y1.y)} * g1;
                v[u][j] = xv * ALPHA + gv * yv; } }
#pragma unroll
        for (int u = 0; u < 2; ++u) { float s = 0.f;
#pragma unroll
            for (int j = 0; j < 8; ++j) s += (v[u][j][0] + v[u][j][1]) + (v[u][j][2] + v[u][j][3]);
            mean[u] = wave_sum(s) * (1.f / D); float q = 0.f;
#pragma unroll
            for (int j = 0; j < 8; ++j) { v[u][j] = v[u][j] - mean[u]; q += (v[u][j][0] * v[u][j][0] + v[u][j][1] * v[u][j][1]) + (v[u][j][2] * v[u][j][2] + v[u][j][3] * v[u][j][3]); }
            rstd[u] = rsqrtf(wave_sum(q) * (1.f / D) + LN_EPS); }
#pragma unroll
        for (int j = 0; j < 8; ++j) { const int d = 4 * l + 256 * j; const f32x4 lgv = *(const GAS f32x4*)(lg + d), lbv = *(const GAS f32x4*)(lbias + d);
#pragma unroll
            for (int u = 0; u < 2; ++u) { if (!ok[u]) continue; const int row = rows[u], b = row / SEQ; const float* modn = sm + SM_MOD + ((layer + 1) * 2 + b) * 6 * D;
                const f32x4 o = v[u][j] * rstd[u] * lgv + lbv;
                if constexpr (OB) *(GAS v2u*)(XOB + (size_t)row * D + d) = (v2u){pk2(o[0], o[1]), pk2(o[2], o[3])}; else *(GAS f32x4*)(XO + (size_t)row * D + d) = o;
                if (HXN) { const f32x4 hx = o * (*(const GAS f32x4*)(modn + D + d) + 1.f) + *(const GAS f32x4*)(modn + d); *(GAS v2u*)(HXN + (size_t)row * D + d) = (v2u){pk2(hx[0], hx[1]), pk2(hx[2], hx[3])}; } } }
    }
}
template <int W> __device__ __forceinline__ void pool_item8(const bf16* U, bf16* MX, int t0, int d) {
    const int b = t0 / SEQ, n0 = t0 % SEQ, lo0 = n0 - W / 2;
    v4u x[W + 7];
#pragma unroll
    for (int j = 0; j < W + 7; ++j) { const int p = lo0 + j, pc = p < 0 ? 0 : (p >= SEQ ? SEQ - 1 : p); x[j] = *(const GAS v4u*)(U + (size_t)(b * SEQ + pc) * D + d); }
#pragma unroll
    for (int q = 0; q < 8; ++q) {
        float acc[8] = {0.f, 0.f, 0.f, 0.f, 0.f, 0.f, 0.f, 0.f}; int cnt = 0;
#pragma unroll
        for (int j = 0; j < W; ++j) { const int p = lo0 + q + j; const bool ok = (p >= 0) && (p < SEQ); cnt += ok ? 1 : 0; const v4u v = x[q + j];
            if (ok) { acc[0] += bflo(v.x); acc[1] += bfhi(v.x); acc[2] += bflo(v.y); acc[3] += bfhi(v.y); acc[4] += bflo(v.z); acc[5] += bfhi(v.z); acc[6] += bflo(v.w); acc[7] += bfhi(v.w); } }
        const v4u sv = x[q + W / 2]; const float inv = 1.f / (float)cnt;
        *(GAS v4u*)(MX + (size_t)(t0 + q) * D + d) = (v4u){pk2(acc[0] * inv - bflo(sv.x), acc[1] * inv - bfhi(sv.x)), pk2(acc[2] * inv - bflo(sv.y), acc[3] * inv - bfhi(sv.y)),
                                                      pk2(acc[4] * inv - bflo(sv.z), acc[5] * inv - bfhi(sv.z)), pk2(acc[6] * inv - bflo(sv.w), acc[7] * inv - bfhi(sv.w))};
    }
}
__device__ __forceinline__ void p_pool(const Ctx& F, const Args& a) {
    const bf16* U = (const bf16*)(a.ws + WS_REGA); bf16* MX = (bf16*)(a.ws + WS_REGA) + (size_t)NTOK * D;
    for (int i = F.vcu * NTHR + F.tid; i < (NTOK / 8) * (D / 8); i += F.G * NTHR) {
        const int t0 = (i >> 8) * 8, d = (i & 255) * 8, g = d >> 9;
        if (g == 0) pool_item8<2>(U, MX, t0, d); else if (g == 1) pool_item8<4>(U, MX, t0, d); else if (g == 2) pool_item8<8>(U, MX, t0, d); else pool_item8<16>(U, MX, t0, d);
    }
}
#ifndef MK_PER_PHASE
#define MK_PER_PHASE 0
#endif
constexpr int NPHASE = 20;
__global__ void __launch_bounds__(NTHR, 2) fwd(Args args) {
    extern __shared__ __attribute__((aligned(16))) unsigned char lds_raw[];
    Ctx F; F.lds = (LAS unsigned char*)lds_raw; F.tid = threadIdx.x; F.lane = F.tid & 63; F.wave = __builtin_amdgcn_readfirstlane(F.tid >> 6);
    F.G = gridDim.x; { const int bx = blockIdx.x; F.vcu = (F.G % 8 == 0) ? (bx % 8) * (F.G / 8) + bx / 8 : bx; }
    unsigned char* ws = args.ws;
    for (int u = F.tid; u < (LDS_BYTES - LDS_CTLB) / 4; u += NTHR) ((LAS unsigned*)(F.lds + LDS_CTLB))[u] = 0u;
    __syncthreads();
    XcdBarrier bar = xcd_barrier_post((unsigned*)(ws + WS_CTL) + CW_BAR + (MK_PER_PHASE ? args.ph_lo : 0) * XCD_BAR_WORDS, (volatile LAS unsigned*)(F.lds + LDS_MISC) + 8);
    const int lo = args.ph_lo, hi = args.ph_hi;
#define IN(k) (lo <= (k) && (k) < hi)
#define REFRESH_CTX() do { int tz_ = threadIdx.x; asm volatile("" : "+v"(tz_)); F.tid = tz_; F.lane = tz_ & 63; F.wave = __builtin_amdgcn_readfirstlane(tz_ >> 6); } while (0)
#define SEAM(k) do { if (IN(k) && IN((k) + 1)) xcd_barrier(bar); } while (0)
    LAS unsigned char* ring = F.lds;
    const int cid = (int)blockIdx.x;
    bf16* HX = (bf16*)(ws + WS_HX); bf16* P16 = (bf16*)(ws + WS_REGA); bf16* CAT = (bf16*)(ws + WS_CAT); bf16* YXb = (bf16*)(ws + WS_YX);
    bf16* X1 = (bf16*)(ws + WS_X1); bf16* X2 = (bf16*)(ws + WS_X2); bf16* TOK = (bf16*)(ws + WS_TOK);
    bf16* XE = (bf16*)(ws + WS_REGA); bf16* Hb = (bf16*)(ws + WS_H); bf16* YS = (bf16*)(ws + WS_REGB);
    bf16* Ub = (bf16*)(ws + WS_REGA); bf16* MXb = Ub + (size_t)NTOK * D; bf16* YGb = MXb + (size_t)NTOK * D;

    if (IN(0)) { REFRESH_CTX(); p0_mod(F, args, 0, 192, F.vcu, F.G, true); p0_router_frags(F, args); p0_convert(F, args, F.vcu, F.G, false, 192); } SEAM(0);
    if (IN(1)) { REFRESH_CTX(); p1_modulate(F, args); } SEAM(1);
    if (IN(2)) { REFRESH_CTX(); {
        constexpr int NWG = pg8::InprojOrder::NWG; const int nfull = NWG / F.G, nbusy = NWG - nfull * F.G, nfree = F.G - nbusy; const bool tail = nfull > 0 && nbusy > 0 && nfree >= 32;
        unsigned* arrive = (unsigned*)(ws + WS_CTL) + CW_INARR;
        pg8::Gemm g{HX, (const bf16*)(ws + WS_WIN), D, D, D}; pg8::InprojOrder S; S.init(F.G, cid, D, D, tail ? arrive : nullptr);
        pg8::EpiBf16 E{P16, MIXW, nullptr, MIXW / 256, C_HQ / 256, C_FF / 256, C_HG / 256, MIXW / 256, C_V / 256, NTOK};
        pg8::gemm_phase<pg8::EpiBf16, pg8::InprojOrder, true, true>(ring, g, S, E);
        if (tail) { const int me = cid - nbusy;
            if (me >= 0 && me < 16) {
                if (threadIdx.x == 0) { unsigned* bw = bar.bar; XB_SPIN(xb_ld(arrive) < (unsigned)pg8::InprojOrder::NCTXU, bw); __builtin_amdgcn_fence(__ATOMIC_ACQUIRE, "agent"); asm volatile("s_waitcnt vmcnt(0)" ::: "memory"); }
                __syncthreads();
                hg_unit<false>(F, args, me >> 3, me & 7, 16);
                __syncthreads();
            }
            p0_mod(F, args, 192, 384, me, nfree, false, (unsigned*)(ws + WS_CTL) + CW_GVQ);
            __syncthreads(); p0_convert(F, args, me, nfree, false, -1);
        } else { p0_mod(F, args, 192, 384, nbusy > 0 ? cid - nbusy : F.vcu, nbusy > 0 ? nfree : F.G, false); __syncthreads(); p0_convert(F, args, F.vcu, F.G, false, -1); xcd_barrier(bar); p_hg_ctx_summaries(F, args, 0, F.G); } } }
    do { if (IN(2) && IN(4)) xcd_barrier(bar); } while (0);
    if (IN(4)) { REFRESH_CTX();
        p4_attn_mfma(F, args); p_hg_summaries(F, args);
    } SEAM(4);
    if (IN(5)) { REFRESH_CTX();
        p_hg_carry(F, args);
    } SEAM(5);
    if (IN(6)) { REFRESH_CTX();
        p_hg_outputs(F, args);
    } SEAM(6);
    if (IN(7)) { REFRESH_CTX(); { pg8::Gemm g{CAT, (const bf16*)(ws + WS_WOUT), D, D, D}; pg8::StaticOrder S; S.init(NTOK, D, F.G, cid, D, D); pg8::EpiBf16 E{YXb, D, nullptr, 8}; pg8::gemm_phase<pg8::EpiBf16, pg8::StaticOrder, true, true>(ring, g, S, E); } } SEAM(7);
    if (IN(8)) { REFRESH_CTX(); p_ln_router<false>(F, args, 0, args.in[0], YXb, X1, TOK); } SEAM(8);
    if (IN(9)) { REFRESH_CTX(); const bool has_slots = F.vcu * NTHR < 2 * NTOK;
        if (has_slots) p_gather(F, args, 0);
        {
          __syncthreads(); const bool sw = (F.G % 8 == 0) && F.G >= 16; const int xi = cid & 7, fold = sw ? (xi ? (cid >> 3) * 7 + xi - 1 : -1) : cid, fstride = sw ? (F.G / 8) * 7 : F.G;
          pg8::Gemm g{(const bf16*)(ws + WS_WPOUT), (const bf16*)(ws + WS_WGRP), 512, D, 512}; pg8::FoldOrder S{fold, fstride, D, 512}; pg8::EpiBf16 E{(bf16*)(ws + WS_WFOLD), D, nullptr, 8};
          pg8::gemm_phase<pg8::EpiBf16, pg8::FoldOrder, true, true>(ring, g, S, E);
          if (sw && fstride >= 128) p0_convert(F, args, fold - 64, fstride - 64, true); else p0_convert(F, args, F.vcu, F.G, true); }
        if (!has_slots) { __syncthreads(); moe_table(F, args, 0, false); } } SEAM(9);
    if (IN(10)) { REFRESH_CTX(); { if (MK_PER_PHASE) moe_table(F, args, 0, false);     pg8::FusedOrder S; S.init((const LAS int*)(F.lds + LDS_TAB), F.G, F.vcu); pg8::MoeCfg c0{TOK, D, (const int*)(ws + WS_SMALL) + SM_SLOTTOK, D, args.in[21] + (size_t)0 * NEXP * D * FF, args.in[22] + (size_t)0 * NEXP * D * FF, FF, (size_t)D * FF, 128, 4}; pg8::MoeCfg c1{Hb, FF, nullptr, FF, args.in[23] + (size_t)0 * NEXP * FF * D, args.in[23] + (size_t)0 * NEXP * FF * D + 128, D, (size_t)FF * D, 256, 8}; pg8::EpiSwiglu EA{Hb}; pg8::EpiBf16 EB{YS, D, nullptr, 8}; pg8::gemm_moe_fused<pg8::EpiSwiglu, pg8::EpiBf16>(ring, c0, c1, (unsigned*)(ws + WS_CTL) + CW_MCNT + 0 * 128, ws + WS_XBUF, (unsigned*)(ws + WS_CTL) + CW_XCNT + 0 * 512, S, EA, EB); } } SEAM(10);
    if (IN(11)) { REFRESH_CTX(); p_ln2<true>(F, args, 0, X2, HX); } SEAM(11);
    if (IN(12)) { REFRESH_CTX(); { pg8::Gemm g{HX, (const bf16*)(ws + WS_WPIN), D, D, D}; pg8::StaticOrder S; S.init(NTOK, D, F.G, cid, D, D);
        if (F.G == (NTOK / 256) * (D / 256)) {
            pg8::EpiPool E{MXb, ws + WS_HALO, (unsigned*)(ws + WS_CTL) + CW_HCNT, D, SEQ / 256}; pg8::gemm_phase<pg8::EpiPool, pg8::StaticOrder, true, true>(ring, g, S, E);
        } else { pg8::EpiBf16 E{Ub, D, nullptr, 8}; pg8::gemm_phase<pg8::EpiBf16, pg8::StaticOrder, true, true>(ring, g, S, E); } } }
    if (IN(12) && IN(13) && F.G != (NTOK / 256) * (D / 256)) xcd_barrier(bar);
    if (IN(13)) { REFRESH_CTX(); if (F.G != (NTOK / 256) * (D / 256)) p_pool(F, args); } do { if (IN(13) && IN(15)) xcd_barrier(bar); } while (0);
    if (IN(15)) { REFRESH_CTX(); { pg8::Gemm g{MXb, (const bf16*)(ws + WS_WFOLD), D, D, D}; pg8::StaticOrder S; S.init(NTOK, D, F.G, cid, D, D); pg8::EpiBf16 E{YXb, D, nullptr, 8}; pg8::gemm_phase<pg8::EpiBf16, pg8::StaticOrder, true, true>(ring, g, S, E); } } SEAM(15);
    if (IN(16)) { REFRESH_CTX(); p_ln_router<true>(F, args, 1, X2, YXb, X1, TOK); } SEAM(16);
    if (IN(17)) { REFRESH_CTX(); p_gather(F, args, 1); } SEAM(17);
    if (IN(18)) { REFRESH_CTX(); { if (MK_PER_PHASE) moe_table(F, args, 1, false);     pg8::FusedOrder S; S.init((const LAS int*)(F.lds + LDS_TAB), F.G, F.vcu); pg8::MoeCfg c0{TOK, D, (const int*)(ws + WS_SMALL) + SM_SLOTTOK, D, args.in[21] + (size_t)1 * NEXP * D * FF, args.in[22] + (size_t)1 * NEXP * D * FF, FF, (size_t)D * FF, 128, 4}; pg8::MoeCfg c1{Hb, FF, nullptr, FF, args.in[23] + (size_t)1 * NEXP * FF * D, args.in[23] + (size_t)1 * NEXP * FF * D + 128, D, (size_t)FF * D, 256, 8}; pg8::EpiSwiglu EA{Hb}; pg8::EpiBf16 EB{YS, D, nullptr, 8}; pg8::gemm_moe_fused<pg8::EpiSwiglu, pg8::EpiBf16>(ring, c0, c1, (unsigned*)(ws + WS_CTL) + CW_MCNT + 1 * 128, ws + WS_XBUF, (unsigned*)(ws + WS_CTL) + CW_XCNT + 1 * 512, S, EA, EB); } } SEAM(18);
    if (IN(19)) { REFRESH_CTX(); p_ln2<false>(F, args, 1, args.out, nullptr); }
#undef IN
#undef SEAM
}

extern "C" void kernel_launch(void* const* d_in, const int* in_sizes, int n_in, void* d_out, int out_size, void* d_ws, size_t ws_size, hipStream_t stream) {
    static int grid = 0;
    if (grid == 0) {
        if (n_in != 24 || ws_size < WS_END) { fprintf(stderr, "kernel_launch: need 24 inputs and >= %zu bytes of workspace (got %d, %zu)\n", (size_t)WS_END, n_in, ws_size); grid = -1; return; }
        int dev = 0, cus = 0;
        if (hipGetDevice(&dev) != hipSuccess || hipDeviceGetAttribute(&cus, hipDeviceAttributeMultiprocessorCount, dev) != hipSuccess) { grid = -1; return; }
        if (hipFuncSetAttribute((const void*)fwd, hipFuncAttributeMaxDynamicSharedMemorySize, LDS_BYTES) != hipSuccess) { fprintf(stderr, "kernel_launch: hipFuncSetAttribute failed\n"); grid = -1; return; }
        int per_cu = 0;
        if (hipOccupancyMaxActiveBlocksPerMultiprocessor(&per_cu, (const void*)fwd, NTHR, LDS_BYTES) != hipSuccess || per_cu < 1) { fprintf(stderr, "kernel_launch: occupancy query says %d blocks per CU\n", per_cu); }
        (void)hipGetLastError();
        grid = cus;
    }
    if (grid < 0) return;
    if (hipMemsetAsync((char*)d_ws + WS_CTL, 0, CTL_ZERO_BYTES, stream) != hipSuccess) return;
    Args a{};
    for (int i = 0; i < 24; ++i) a.in[i] = (const float*)d_in[i];
    a.out = (float*)d_out; a.ws = (unsigned char*)d_ws;
#if MK_PER_PHASE
    for (int p = 0; p < NPHASE; ++p) { a.ph_lo = p; a.ph_hi = p + 1; hipLaunchKernelGGL(fwd, dim3(grid), dim3(NTHR), LDS_BYTES, stream, a); }
#else
    a.ph_lo = 0; a.ph_hi = NPHASE;
    hipLaunchKernelGGL(fwd, dim3(grid), dim3(NTHR), LDS_BYTES, stream, a);
#endif
    const hipError_t le = hipPeekAtLastError();
    if (le != hipSuccess) fprintf(stderr, "kernel_launch: launch failed: %s\n", hipGetErrorName(le));
}
```
